# Optimizing an MI355X kernel written in HIP

```python
import math
import jax, jax.numpy as jnp
from jax import lax
import numpy as np

D_MODEL = 2048
BATCH = 4
SEQ = 4096
DEPTH = 1
DEC_BATCH = 16
DEC_SEQ = 64
PAST_LEN = 1024

CHUNK = 64
N_HEADS_A = 8
D_QK = 64
D_V = 2 * D_QK
WIDTH_A = N_HEADS_A * D_V
WIDTH_B = D_MODEL // 2
CONV_W = 3
D_FF = 5632
FFN_CONV_W = 3
N_BUCKETS = 32
MAX_DIST = 128
Q_BLOCK = 128
EPS = 1e-6
NEG_INF = -1e30
SPLIT_SIZES = (N_HEADS_A * 2 * D_QK, N_HEADS_A * 2 * D_QK, WIDTH_A, WIDTH_B, WIDTH_B, WIDTH_B, D_MODEL, D_MODEL)
IN_WIDTH = sum(SPLIT_SIZES)

kernel_name = "streaming_diffattn_shortconv_convffn"


def rms_norm(x, g):
    xf = x.astype(jnp.float32)
    y = xf * lax.rsqrt(jnp.mean(xf * xf, axis=-1, keepdims=True) + EPS)
    return (y * g.astype(jnp.float32)).astype(x.dtype)


def lambda_init_for(layer_idx):
    return 0.8 - 0.6 * math.exp(-0.3 * layer_idx)


def rel_bucket(rel):
    nb = N_BUCKETS // 2
    max_exact = nb // 2
    ret = jnp.where(rel > 0, nb, 0)
    n = jnp.abs(rel)
    large = max_exact + (jnp.log(jnp.maximum(n, 1).astype(jnp.float32) / max_exact)
                         / math.log(MAX_DIST / max_exact) * (nb - max_exact)).astype(jnp.int32)
    large = jnp.minimum(large, nb - 1)
    return ret + jnp.where(n < max_exact, n, large)


def position_bias(rel_bias, q_pos, k_pos):
    b = rel_bucket(k_pos[None, :] - q_pos[:, None])
    return jnp.transpose(rel_bias[b], (2, 0, 1)).astype(jnp.float32)


def diff_attn_core(q, k, v, q_pos, k_pos, rel_bias, lam):
    scale = D_QK ** -0.5
    q1, q2 = jnp.split(q, 2, axis=-1)
    k1, k2 = jnp.split(k, 2, axis=-1)
    bias = position_bias(rel_bias, q_pos, k_pos)
    mask = (k_pos[None, :] // CHUNK) <= (q_pos[:, None] // CHUNK)

    def probs(qa, ka):
        s = jnp.einsum('bqhd,bkhd->bhqk', qa, ka, preferred_element_type=jnp.float32) * scale + bias
        s = jnp.where(mask, s, NEG_INF)
        return jax.nn.softmax(s, axis=-1)

    a = probs(q1, k1) - lam * probs(q2, k2)
    return jnp.einsum('bhqk,bkhd->bqhd', a.astype(v.dtype), v)


def diff_attn_prompt(q, k, v, rel_bias, lam):
    B, S, H, _ = q.shape
    nblk = S // Q_BLOCK
    k_pos = jnp.arange(S)
    qb = q.reshape(B, nblk, Q_BLOCK, H, q.shape[-1]).swapaxes(0, 1)
    starts = jnp.arange(nblk) * Q_BLOCK

    def one(args):
        qi, s0 = args
        return diff_attn_core(qi, k, v, s0 + jnp.arange(Q_BLOCK), k_pos, rel_bias, lam)

    o = lax.map(one, (qb, starts))
    return o.swapaxes(0, 1).reshape(B, S, H, v.shape[-1])


def causal_dwconv(x, prev, w):
    T = x.shape[1]
    W = w.shape[0]
    xp = jnp.concatenate([prev.astype(x.dtype), x], axis=1)
    y = xp[:, 0:T] * w[0]
    for j in range(1, W):
        y = y + xp[:, j:j + T] * w[j]
    return y, xp[:, T:]


def split_cols(proj):
    out, off = [], 0
    for s in SPLIT_SIZES:
        out.append(proj[..., off:off + s])
        off += s
    return out


def trunk_layer(x, k_past, v_past, conv_prev, ffn_prev, rel_bias, lambda_init,
                norm1_g, w_in, lambda_q1, lambda_k1, lambda_q2, lambda_k2, subln_g,
                conv_w, w_proj_a, w_proj_b, w_o, norm2_g, w_up, ffn_conv_w, w_down):
    B, T, _ = x.shape
    xn = rms_norm(x, norm1_g)
    q, k, v, b_gate, c_gate, x_in, g_a, g_b = split_cols(xn @ w_in)
    q = q.reshape(B, T, N_HEADS_A, 2 * D_QK)
    k = k.reshape(B, T, N_HEADS_A, 2 * D_QK)
    v = v.reshape(B, T, N_HEADS_A, D_V)
    lam = (jnp.exp(jnp.sum(lambda_q1.astype(jnp.float32) * lambda_k1.astype(jnp.float32)))
           - jnp.exp(jnp.sum(lambda_q2.astype(jnp.float32) * lambda_k2.astype(jnp.float32)))
           + lambda_init)
    if k_past is None:
        o = diff_attn_prompt(q, k, v, rel_bias, lam)
    else:
        P = k_past.shape[1]
        keys = jnp.concatenate([k_past.astype(k.dtype), k], axis=1)
        vals = jnp.concatenate([v_past.astype(v.dtype), v], axis=1)
        o = diff_attn_core(q, keys, vals, P + jnp.arange(T), jnp.arange(P + T), rel_bias, lam)
    o = rms_norm(o, subln_g) * (1.0 - lambda_init)
    o = o.reshape(B, T, WIDTH_A)
    u = c_gate * x_in
    if conv_prev is None:
        conv_prev = jnp.zeros((B, CONV_W - 1, WIDTH_B), u.dtype)
    z, conv_state = causal_dwconv(u, conv_prev, conv_w)
    ob = b_gate * z
    merged = jax.nn.sigmoid(g_a) * (o @ w_proj_a) + jax.nn.sigmoid(g_b) * (ob @ w_proj_b)
    h = x + merged @ w_o
    hn = rms_norm(h, norm2_g)
    up = hn @ w_up
    if ffn_prev is None:
        ffn_prev = jnp.zeros((B, FFN_CONV_W - 1, 2 * D_FF), up.dtype)
    upc, ffn_state = causal_dwconv(up, ffn_prev, ffn_conv_w)
    gate, val = jnp.split(upc, 2, axis=-1)
    h = h + (jax.nn.silu(gate) * val) @ w_down
    return h, k, v, conv_state, ffn_state


def setup_inputs(seed: int = 0) -> dict:
    key = jax.random.key(seed)
    ks = jax.random.split(key, 24)
    f32 = jnp.float32
    nrm = lambda k, shp, s: jax.random.normal(k, shp, f32) * s
    return {
        "x_prompt": nrm(ks[0], (BATCH, SEQ, D_MODEL), 1.0),
        "x_sample": nrm(ks[1], (DEC_BATCH, DEC_SEQ, D_MODEL), 1.0),
        "cache_k": nrm(ks[2], (DEPTH, DEC_BATCH, PAST_LEN, N_HEADS_A, 2 * D_QK), 1.0),
        "cache_v": nrm(ks[3], (DEPTH, DEC_BATCH, PAST_LEN, N_HEADS_A, D_V), 1.0),
        "state_conv_mix": nrm(ks[4], (DEPTH, DEC_BATCH, CONV_W - 1, WIDTH_B), 1.0),
        "state_conv_ffn": nrm(ks[5], (DEPTH, DEC_BATCH, FFN_CONV_W - 1, 2 * D_FF), 1.0),
        "rel_bias": nrm(ks[6], (N_BUCKETS, N_HEADS_A), 0.5),
        "norm1_g": 1.0 + nrm(ks[7], (DEPTH, D_MODEL), 0.02),
        "w_in": nrm(ks[8], (DEPTH, D_MODEL, IN_WIDTH), D_MODEL ** -0.5),
        "lambda_q1": nrm(ks[9], (DEPTH, D_QK), 0.1),
        "lambda_k1": nrm(ks[10], (DEPTH, D_QK), 0.1),
        "lambda_q2": nrm(ks[11], (DEPTH, D_QK), 0.1),
        "lambda_k2": nrm(ks[12], (DEPTH, D_QK), 0.1),
        "subln_g": 1.0 + nrm(ks[13], (DEPTH, D_V), 0.02),
        "conv_w": nrm(ks[14], (DEPTH, CONV_W, WIDTH_B), CONV_W ** -0.5),
        "w_proj_a": nrm(ks[15], (DEPTH, WIDTH_A, D_MODEL), WIDTH_A ** -0.5),
        "w_proj_b": nrm(ks[16], (DEPTH, WIDTH_B, D_MODEL), WIDTH_B ** -0.5),
        "w_o": nrm(ks[17], (DEPTH, D_MODEL, D_MODEL), D_MODEL ** -0.5),
        "norm2_g": 1.0 + nrm(ks[18], (DEPTH, D_MODEL), 0.02),
        "w_up": nrm(ks[19], (DEPTH, D_MODEL, 2 * D_FF), D_MODEL ** -0.5),
        "ffn_conv_w": nrm(ks[20], (DEPTH, FFN_CONV_W, 2 * D_FF), FFN_CONV_W ** -0.5),
        "w_down": nrm(ks[21], (DEPTH, D_FF, D_MODEL), D_FF ** -0.5),
        "final_g": 1.0 + nrm(ks[22], (D_MODEL,), 0.02),
    }


def reference(x_prompt, x_sample, cache_k, cache_v, state_conv_mix, state_conv_ffn, rel_bias,
              norm1_g, w_in, lambda_q1, lambda_k1, lambda_q2, lambda_k2, subln_g, conv_w,
              w_proj_a, w_proj_b, w_o, norm2_g, w_up, ffn_conv_w, w_down, final_g):
    hp, hs = x_prompt, x_sample
    kp_l, vp_l, cmp_l, cfp_l = [], [], [], []
    ks_l, vs_l, cms_l, cfs_l = [], [], [], []
    for d in range(DEPTH):
        lp = (norm1_g[d], w_in[d], lambda_q1[d], lambda_k1[d], lambda_q2[d], lambda_k2[d], subln_g[d],
              conv_w[d], w_proj_a[d], w_proj_b[d], w_o[d], norm2_g[d], w_up[d], ffn_conv_w[d], w_down[d])
        li = lambda_init_for(d)
        hp, kp, vp, cmp_, cfp = trunk_layer(hp, None, None, None, None, rel_bias, li, *lp)
        hs, ks_, vs_, cms, cfs = trunk_layer(hs, cache_k[d], cache_v[d], state_conv_mix[d],
                                             state_conv_ffn[d], rel_bias, li, *lp)
        kp_l.append(kp); vp_l.append(vp); cmp_l.append(cmp_); cfp_l.append(cfp)
        ks_l.append(ks_); vs_l.append(vs_); cms_l.append(cms); cfs_l.append(cfs)
    y_prompt = rms_norm(hp, final_g)
    y_sample = rms_norm(hs, final_g)
    return (y_prompt, y_sample,
            jnp.stack(kp_l), jnp.stack(vp_l), jnp.stack(cmp_l), jnp.stack(cfp_l),
            jnp.stack(ks_l), jnp.stack(vs_l), jnp.stack(cms_l), jnp.stack(cfs_l))
```

```cpp
#include <hip/hip_runtime.h>
#include <hip/hip_cooperative_groups.h>
#include <cstdio>
#include <cstdint>
namespace cg = cooperative_groups;

#ifndef PROBE_DUP
#define PROBE_DUP 0
#endif
#ifndef MK_MULTI
#define MK_MULTI 0
#endif

#define LAS __attribute__((address_space(3)))
typedef unsigned short bf16_t;
typedef short bf16x8 __attribute__((ext_vector_type(8)));
typedef float f32x4 __attribute__((ext_vector_type(4)));
typedef float f32x16 __attribute__((ext_vector_type(16)));
typedef unsigned u32x4 __attribute__((ext_vector_type(4)));
typedef unsigned u32x2 __attribute__((ext_vector_type(2)));
typedef float f32x2_t __attribute__((ext_vector_type(2)));
typedef __bf16 bf16x2_t __attribute__((ext_vector_type(2)));

constexpr int DM = 2048, NBATCH = 4, SEQ = 4096, DBATCH = 16, DSEQ = 64, PAST = 1024;
constexpr int MP = NBATCH * SEQ, MS = DBATCH * DSEQ, MTOT = MP + MS;
constexpr int NH = 8, DV = 128, DFF = 5632, NIN = 10240, PLD = 9216;
constexpr float EPS = 1e-6f;
constexpr float LOG2E = 1.4426950408889634f;
constexpr int PC_Q = 0, PC_K = 1024, PC_B = 2048, PC_C = 3072, PC_X = 4096, PC_GA = 5120, PC_GB = 7168;
constexpr size_t O_Y = 0;
constexpr size_t O_KP = (size_t)MTOT * DM;
constexpr size_t O_VP = O_KP + (size_t)MP * 1024;
constexpr size_t O_CMP = O_VP + (size_t)MP * 1024;
constexpr size_t O_CFP = O_CMP + (size_t)NBATCH * 2 * 1024;
constexpr size_t O_KS = O_CFP + (size_t)NBATCH * 2 * 2 * DFF;
constexpr size_t O_VS = O_KS + (size_t)MS * 1024;
constexpr size_t O_CMS = O_VS + (size_t)MS * 1024;
constexpr size_t O_CFS = O_CMS + (size_t)DBATCH * 2 * 1024;
constexpr size_t O_END = O_CFS + (size_t)DBATCH * 2 * 2 * DFF;
constexpr size_t MiB = 1u << 20;
constexpr size_t WS_CTL = 0, CTL_BYTES = 1 * MiB;
constexpr size_t WS_ROWSS = 64 * 1024;
constexpr size_t WS_RSTD1 = 512 * 1024;
constexpr size_t WS_WIN = 1 * MiB;
constexpr size_t WS_WAB = 41 * MiB;
constexpr size_t WS_WO = 49 * MiB;
constexpr size_t WS_PROJ = 57 * MiB;
constexpr size_t WS_KC = 363 * MiB;
constexpr size_t WS_VTC = 395 * MiB;
constexpr size_t WS_VTP = 427 * MiB;
constexpr size_t WS_VTN = 459 * MiB;
constexpr size_t WS_MERGED = 363 * MiB;
constexpr size_t WS_WUP = 431 * MiB;
constexpr size_t WS_WDN = 475 * MiB;
constexpr size_t WS_HB = 57 * MiB;
constexpr size_t WS_ACT = 125 * MiB;
constexpr size_t WS_TH = 312 * MiB;
constexpr size_t WS_SCR6 = 363 * MiB;
constexpr size_t WS_END = 497 * MiB;

constexpr int LDS_BYTES = 156160;
constexpr int XB_OFF = 131072;
constexpr int TAB_OFF = 147456;
constexpr int MISC_OFF = 155648;

__device__ __forceinline__ unsigned cvtpk(float lo, float hi) { f32x2_t v = {lo, hi}; bf16x2_t b = __builtin_convertvector(v, bf16x2_t); return __builtin_bit_cast(unsigned, b); }
__device__ __forceinline__ float bf2f(unsigned short b) { return __builtin_bit_cast(float, (unsigned)b << 16); }
__device__ __forceinline__ float bflo(unsigned w) { return __builtin_bit_cast(float, w << 16); }
__device__ __forceinline__ float bfhi(unsigned w) { return __builtin_bit_cast(float, w & 0xffff0000u); }
__device__ __forceinline__ float sigmoidf_(float x) { return __builtin_amdgcn_rcpf(1.0f + __builtin_amdgcn_exp2f(-x * LOG2E)); }
__device__ __forceinline__ void swap32(float& a, float& b) { asm volatile("s_nop 1\n\tv_permlane32_swap_b32 %0, %1\n\ts_nop 1" : "+v"(a), "+v"(b)); }
template <int CTRL> __device__ __forceinline__ float dppf(float v) { return __builtin_bit_cast(float, __builtin_amdgcn_update_dpp(0, __builtin_bit_cast(int, v), CTRL, 0xf, 0xf, true)); }

namespace pg8 {
constexpr int BM = 256, BK = 64, HALF = 128, HTB = HALF * BK * 2, STAGE_BYTES = 8 * HTB, NXCD = 8, WGM = 8;
__host__ __device__ __forceinline__ int lds_byte(int r, int c) { const int st = (r >> 4) * 2 + (c >> 5), rr = r & 15, cc = c & 31, ob = rr * 64 + cc * 2; return st * 1024 + (ob ^ (((ob >> 9) & 1) << 5)); }
__host__ __device__ __forceinline__ void stage_rc(int b, int& R, int& C) { const int st = b / 1024, sb = b % 1024, swz = sb ^ (((sb >> 9) & 1) << 5); R = (st >> 1) * 16 + swz / 64; C = (st & 1) * 32 + (swz % 64) / 2; }
__host__ __device__ __forceinline__ int perm32(int rho) { const int n = rho >> 4, i = rho & 15; return 8 * (i >> 2) + 4 * n + (i & 3); }

struct Unit { int pm, pn, ra, cb; };
struct Gemm { const bf16_t* A; const bf16_t* Bt; int lda, ldb, K; };
struct StaticOrder {
    int nM, nN, nwg, G, c, lim;
    __device__ void init(int nM_, int nN_, int G_, int c_, int lim_ = 0x7fffffff) { nM = nM_; nN = nN_; nwg = nM * nN; G = G_; c = c_; lim = lim_ < nwg ? lim_ : nwg; }
    __device__ void unit_of(int L, Unit& u) const {
        int wgid = L; { const int q = nwg / NXCD, r = nwg % NXCD, xcd = wgid % NXCD, off = wgid / NXCD; wgid = (xcd < r ? xcd * (q + 1) : r * (q + 1) + (xcd - r) * q) + off; }
        const int nig = WGM * nN, gid = wgid / nig, fm = gid * WGM, gsz = (nM - fm) < WGM ? (nM - fm) : WGM;
        u.pm = fm + ((wgid % nig) % gsz); u.pn = (wgid % nig) / gsz; u.ra = 0; u.cb = 0;
    }
    __device__ bool next(int i, Unit& u) const {
        const long L = (long)i * G + c; if (L >= lim) return false;
        unit_of((int)L, u); return true;
    }
};

template <class Epi>
__device__ __forceinline__ void gemm_phase(LAS unsigned char* lds, const Gemm g, const StaticOrder& S, const Epi& E) {
    const int tid = threadIdx.x, wid = __builtin_amdgcn_readfirstlane(tid >> 6), lane = tid & 63, wr = wid >> 2, wc = wid & 3, fr = lane & 15, fq = lane >> 4;
    const int K = g.K, nt = K / BK;
    unsigned voffA[2], voffB[2];
#pragma unroll
    for (int i = 0; i < 2; ++i) { int R, C; stage_rc(tid * 16 + i * 8192, R, C); const int Rb = (R & ~31) + perm32(R & 31);
        voffA[i] = (unsigned)(R * g.lda + C) * 2u; voffB[i] = (unsigned)(Rb * g.ldb + C) * 2u; }
    const size_t kstep = (size_t)(BK * 2);
    const size_t hstepA = (size_t)HALF * g.lda * 2, hstepB = (size_t)HALF * g.ldb * 2;
    const size_t tstepA = 2 * hstepA, tstepB = 2 * hstepB;
    const unsigned ldsw = (unsigned)wid * 1024u;
    const int aoff = lds_byte(wr * 64 + fr, fq * 8), boff = lds_byte(wc * 32 + fr, fq * 8);
#define PG8_SA(b, h) (((b) * 2 + (h)) * HTB)
#define PG8_SB(b, h) ((4 + (b) * 2 + (h)) * HTB)
#define PG8_STAGE(bufoff, gbase, voff) do { _Pragma("unroll") for (int _i = 0; _i < 2; ++_i) \
        __builtin_amdgcn_global_load_lds((const unsigned*)((const char*)(gbase) + (voff)[_i]), (LAS unsigned*)(lds + (bufoff) + ldsw + _i * 8192), 16, 0, 0); } while (0)
#define PG8_LDA(dst, b, h) do { _Pragma("unroll") for (int m = 0; m < 4; ++m) _Pragma("unroll") for (int k = 0; k < 2; ++k) dst[m][k] = *(const LAS bf16x8*)(lds + PG8_SA(b, h) + aoff + m * 2048 + k * 1024); } while (0)
#define PG8_LDB(dst, b, h) do { _Pragma("unroll") for (int n = 0; n < 2; ++n) _Pragma("unroll") for (int k = 0; k < 2; ++k) dst[n][k] = *(const LAS bf16x8*)(lds + PG8_SB(b, h) + boff + n * 2048 + k * 1024); } while (0)
#define PG8_MMA(ai, bj, At, Bt) do { __builtin_amdgcn_s_setprio(1); _Pragma("unroll") for (int m = 0; m < 4; ++m) _Pragma("unroll") for (int n = 0; n < 2; ++n) _Pragma("unroll") for (int k = 0; k < 2; ++k) \
        acc[ai][bj][m][n] = __builtin_amdgcn_mfma_f32_16x16x32_bf16(Bt[n][k], At[m][k], acc[ai][bj][m][n], 0, 0, 0); __builtin_amdgcn_s_setprio(0); } while (0)
#define PG8_WAIT_V(n) asm volatile("s_waitcnt vmcnt(" #n ")" ::: "memory")
#define PG8_WAIT_L(n) asm volatile("s_waitcnt lgkmcnt(" #n ")" ::: "memory")
#define PG8_BAR __builtin_amdgcn_s_barrier()
#define PG8_SCHED __builtin_amdgcn_sched_barrier(0)
    Unit cur, nxt; int ui = 0;
    if (!S.next(0, cur)) return;
    f32x4 acc[2][2][4][2];
#pragma unroll
    for (int a = 0; a < 2; ++a)
#pragma unroll
        for (int b = 0; b < 2; ++b)
#pragma unroll
            for (int m = 0; m < 4; ++m)
#pragma unroll
                for (int n = 0; n < 2; ++n) acc[a][b][m][n] = (f32x4){0.f, 0.f, 0.f, 0.f};
    bf16x8 At[4][2], B0[2][2], B1[2][2];
    const char* cA = (const char*)g.A + (size_t)cur.pm * tstepA; const char* cB = (const char*)g.Bt + (size_t)cur.pn * tstepB;
    PG8_STAGE(PG8_SB(0, 0), cB, voffB); PG8_STAGE(PG8_SB(0, 1), cB + hstepB, voffB); PG8_STAGE(PG8_SA(0, 0), cA, voffA); PG8_STAGE(PG8_SA(0, 1), cA + hstepA, voffA);
    if (wr == 1) PG8_BAR;
    PG8_WAIT_V(2); PG8_BAR;
    PG8_STAGE(PG8_SB(1, 0), cB + kstep, voffB); PG8_STAGE(PG8_SA(1, 0), cA + kstep, voffA); PG8_STAGE(PG8_SB(1, 1), cB + hstepB + kstep, voffB);
    PG8_WAIT_V(6); PG8_BAR;
#define PG8_KLOOP(cA_, cB_, nA_, nB_) \
        for (int t = 0; t < nt; t += 2) { \
            const bool last = (t == nt - 2); \
            const char* a1 = (cA_) + (size_t)(t + 1) * kstep; \
            const char* a2 = last ? (nA_) : (cA_) + (size_t)(t + 2) * kstep; const char* b2 = last ? (nB_) : (cB_) + (size_t)(t + 2) * kstep; \
            const char* a3 = a2 + kstep; const char* b3 = b2 + kstep; \
            PG8_LDB(B0, 0, 0); PG8_LDB(B1, 0, 1); PG8_SCHED; PG8_LDA(At, 0, 0); PG8_STAGE(PG8_SA(1, 1), a1 + hstepA, voffA); \
            PG8_WAIT_V(8); PG8_WAIT_L(0); PG8_BAR; PG8_MMA(0, 0, At, B0); PG8_MMA(0, 1, At, B1); PG8_BAR; PG8_SCHED; \
            PG8_LDA(At, 0, 1); PG8_STAGE(PG8_SB(0, 0), b2, voffB); PG8_STAGE(PG8_SB(0, 1), b2 + hstepB, voffB); PG8_STAGE(PG8_SA(0, 0), a2, voffA); \
            PG8_WAIT_V(8); PG8_WAIT_L(0); PG8_BAR; PG8_MMA(1, 0, At, B0); PG8_MMA(1, 1, At, B1); PG8_BAR; PG8_SCHED; \
            PG8_LDB(B0, 1, 0); PG8_LDB(B1, 1, 1); PG8_SCHED; PG8_LDA(At, 1, 0); PG8_STAGE(PG8_SA(0, 1), a2 + hstepA, voffA); \
            PG8_WAIT_V(8); PG8_WAIT_L(0); PG8_BAR; PG8_MMA(0, 0, At, B0); PG8_MMA(0, 1, At, B1); PG8_BAR; PG8_SCHED; \
            PG8_LDA(At, 1, 1); PG8_STAGE(PG8_SB(1, 0), b3, voffB); PG8_STAGE(PG8_SB(1, 1), b3 + hstepB, voffB); PG8_STAGE(PG8_SA(1, 0), a3, voffA); \
            PG8_WAIT_V(8); PG8_WAIT_L(0); PG8_BAR; PG8_MMA(1, 0, At, B0); PG8_MMA(1, 1, At, B1); PG8_BAR; PG8_SCHED; \
        }
    for (;;) {
        if constexpr (Epi::NPART == 2) {
            const char* mA = cA + (size_t)K * 2; const char* mB = cB + (size_t)K * 2;
            PG8_KLOOP(cA, cB, mA, mB)
            E.mid(acc, cur, wr, wc, fr, fq);
            cA = mA; cB = mB;
        }
        const bool has_next = S.next(ui + 1, nxt);
        const char* nA = has_next ? (const char*)g.A + (size_t)nxt.pm * tstepA : cA; const char* nB = has_next ? (const char*)g.Bt + (size_t)nxt.pn * tstepB : cB;
        PG8_KLOOP(cA, cB, nA, nB)
        if (wr == 0) PG8_BAR;
        E(acc, cur, wr, wc, fr, fq);
        if (!has_next) break;
#pragma unroll
        for (int a = 0; a < 2; ++a)
#pragma unroll
            for (int b = 0; b < 2; ++b)
#pragma unroll
                for (int m = 0; m < 4; ++m)
#pragma unroll
                    for (int n = 0; n < 2; ++n) acc[a][b][m][n] = (f32x4){0.f, 0.f, 0.f, 0.f};
        cur = nxt; cA = nA; cB = nB; ++ui;
        if (wr == 1) PG8_BAR;
    }
#undef PG8_KLOOP
    PG8_WAIT_V(0);
    PG8_BAR;
#undef PG8_SA
#undef PG8_SB
#undef PG8_STAGE
#undef PG8_LDA
#undef PG8_LDB
#undef PG8_MMA
#undef PG8_WAIT_V
#undef PG8_WAIT_L
#undef PG8_BAR
#undef PG8_SCHED
}

template <class Epi>
__device__ __forceinline__ void gemm_quarter(LAS unsigned char* lds, const Gemm g, const Unit u, const Epi& E) {
    const int tid = threadIdx.x, wid = __builtin_amdgcn_readfirstlane(tid >> 6), lane = tid & 63, wr = wid >> 2, wc = wid & 3, fr = lane & 15, fq = lane >> 4;
    const int K = g.K, nt = K / BK;
    unsigned voffA[2], voffB[2];
#pragma unroll
    for (int i = 0; i < 2; ++i) { int R, C; stage_rc(tid * 16 + i * 8192, R, C); const int Rb = (R & ~31) + perm32(R & 31);
        voffA[i] = (unsigned)(R * g.lda + C) * 2u; voffB[i] = (unsigned)(Rb * g.ldb + C) * 2u; }
    const unsigned ldsw = (unsigned)wid * 1024u;
    const int aoff = lds_byte(wr * 64 + fr, fq * 8), boff = lds_byte(wc * 32 + fr, fq * 8);
    const char* cA = (const char*)g.A + ((size_t)u.pm * 256 + u.ra) * g.lda * 2; const char* cB = (const char*)g.Bt + ((size_t)u.pn * 256 + u.cb) * g.ldb * 2;
    f32x4 acc[2][2][4][2];
#pragma unroll
    for (int m = 0; m < 4; ++m)
#pragma unroll
        for (int n = 0; n < 2; ++n) acc[0][0][m][n] = (f32x4){0.f, 0.f, 0.f, 0.f};
#define QSTAGE(r, kt) do { _Pragma("unroll") for (int _i = 0; _i < 2; ++_i) { \
        __builtin_amdgcn_global_load_lds((const unsigned*)(cA + (size_t)(kt) * (BK * 2) + voffA[_i]), (LAS unsigned*)(lds + (r) * HTB + ldsw + _i * 8192), 16, 0, 0); \
        __builtin_amdgcn_global_load_lds((const unsigned*)(cB + (size_t)(kt) * (BK * 2) + voffB[_i]), (LAS unsigned*)(lds + (4 + (r)) * HTB + ldsw + _i * 8192), 16, 0, 0); } } while (0)
    for (int part = 0; part < Epi::NPART; ++part) {
        QSTAGE(0, 0); QSTAGE(1, 1); QSTAGE(2, 2);
        for (int t = 0; t < nt; ++t) {
            if (t + 3 < nt) { QSTAGE((t + 3) & 3, t + 3); asm volatile("s_waitcnt vmcnt(12)" ::: "memory"); }
            else if (t + 2 < nt) asm volatile("s_waitcnt vmcnt(8)" ::: "memory");
            else if (t + 1 < nt) asm volatile("s_waitcnt vmcnt(4)" ::: "memory");
            else asm volatile("s_waitcnt vmcnt(0)" ::: "memory");
            __builtin_amdgcn_s_barrier();
            const int r = t & 3;
            bf16x8 At[4][2], B0[2][2];
#pragma unroll
            for (int m = 0; m < 4; ++m)
#pragma unroll
                for (int k = 0; k < 2; ++k) At[m][k] = *(const LAS bf16x8*)(lds + r * HTB + aoff + m * 2048 + k * 1024);
#pragma unroll
            for (int n = 0; n < 2; ++n)
#pragma unroll
                for (int k = 0; k < 2; ++k) B0[n][k] = *(const LAS bf16x8*)(lds + (4 + r) * HTB + boff + n * 2048 + k * 1024);
            asm volatile("s_waitcnt lgkmcnt(0)" ::: "memory");
#pragma unroll
            for (int m = 0; m < 4; ++m)
#pragma unroll
                for (int n = 0; n < 2; ++n)
#pragma unroll
                    for (int k = 0; k < 2; ++k) acc[0][0][m][n] = __builtin_amdgcn_mfma_f32_16x16x32_bf16(B0[n][k], At[m][k], acc[0][0][m][n], 0, 0, 0);
            __builtin_amdgcn_s_barrier();
        }
        if constexpr (Epi::NPART > 1) { if (part + 1 < Epi::NPART) { E.template mid<1, 1>(acc, u, wr, wc, fr, fq); cA += (size_t)K * 2; cB += (size_t)K * 2; } }
    }
#undef QSTAGE
    E.template operator()<1, 1>(acc, u, wr, wc, fr, fq);
}
}
using pg8::Unit;

#define EPI_ARGS f32x4 (&acc)[2][2][4][2], const Unit& u, int wr, int wc, int fr, int fq
__device__ __forceinline__ void store_bf8(bf16_t* p, f32x4 v0, f32x4 v1) {
    u32x4 w; w.x = cvtpk(v0[0], v0[1]); w.y = cvtpk(v0[2], v0[3]); w.z = cvtpk(v1[0], v1[1]); w.w = cvtpk(v1[2], v1[3]); *(u32x4*)p = w;
}

struct Epi1 {
    static constexpr int NPART = 1;
    bf16_t* proj; float* out; bf16_t* vtp; bf16_t* vtn; const float* rstd1;
    __device__ __forceinline__ void operator()(EPI_ARGS) const {
        const int pn = u.pn; const bool samp = u.pm >= 64;
        const int colt = pn * 256 + wc * 32 + 8 * fq;
#pragma unroll
        for (int ai = 0; ai < 2; ++ai)
#pragma unroll
            for (int m = 0; m < 4; ++m) {
                const int row = u.pm * 256 + ai * 128 + wr * 64 + m * 16 + fr;
                { const float rs = rstd1[row];
#pragma unroll
                  for (int bj = 0; bj < 2; ++bj) { acc[ai][bj][m][0] *= rs; acc[ai][bj][m][1] *= rs; } }
                if (pn >= 24) {
                    const int ch0 = (pn - 24) * 128 + wc * 32 + 8 * fq; f32x4 r0, r1, s0, s1;
#pragma unroll
                    for (int e = 0; e < 4; ++e) {
                        const float ea0 = __builtin_amdgcn_exp2f(-acc[ai][0][m][0][e] * LOG2E), eb0 = __builtin_amdgcn_exp2f(-acc[ai][1][m][0][e] * LOG2E);
                        const float ea1 = __builtin_amdgcn_exp2f(-acc[ai][0][m][1][e] * LOG2E), eb1 = __builtin_amdgcn_exp2f(-acc[ai][1][m][1][e] * LOG2E);
                        r0[e] = (1.f + eb0) * __builtin_amdgcn_rcpf(1.f + ea0); r1[e] = (1.f + eb1) * __builtin_amdgcn_rcpf(1.f + ea1);
                        s0[e] = __builtin_amdgcn_rcpf(1.f + eb0); s1[e] = __builtin_amdgcn_rcpf(1.f + eb1);
                    }
                    store_bf8(proj + (size_t)row * PLD + PC_GA + ch0, r0, r1); store_bf8(proj + (size_t)row * PLD + PC_GB + ch0, s0, s1);
                    continue;
                }
                if (pn >= 16) {
                    const int ch0 = (pn - 16) * 128 + wc * 32 + 8 * fq;
                    store_bf8(proj + (size_t)row * PLD + PC_C + ch0, acc[ai][0][m][0] * acc[ai][1][m][0], acc[ai][0][m][1] * acc[ai][1][m][1]);
                    continue;
                }
#pragma unroll
                for (int bj = 0; bj < 2; ++bj) {
                    const int col = colt + bj * 128; const f32x4 v0 = acc[ai][bj][m][0], v1 = acc[ai][bj][m][1];
                    if (pn < 8 || pn >= 12) { const int pcol = col < 2048 ? col : col - 1024; store_bf8(proj + (size_t)row * PLD + pcol, v0, v1); }
                    if (pn >= 4 && pn < 8) {
                        float* o = samp ? out + O_KS + (size_t)(row - MP) * 1024 + (col - 1024) : out + O_KP + (size_t)row * 1024 + (col - 1024);
                        *(f32x4*)o = v0; *(f32x4*)(o + 4) = v1;
                    }
                    if (pn >= 8 && pn < 12) {
                        const int cv = col - 2048;
                        float* o = samp ? out + O_VS + (size_t)(row - MP) * 1024 + cv : out + O_VP + (size_t)row * 1024 + cv;
                        *(f32x4*)o = v0; *(f32x4*)(o + 4) = v1;
                        bf16_t* vt; size_t pitch;
                        if (samp) { const int r2 = row - MP; vt = vtn + ((size_t)(r2 >> 6) * 1024 + cv) * 64 + (r2 & 63); pitch = 64; }
                        else { vt = vtp + ((size_t)(row >> 12) * 1024 + cv) * 4096 + (row & 4095); pitch = 4096; }
#pragma unroll
                        for (int e = 0; e < 4; ++e) { vt[(size_t)e * pitch] = (bf16_t)(cvtpk(v0[e], 0.f) & 0xffffu); vt[(size_t)(e + 4) * pitch] = (bf16_t)(cvtpk(v1[e], 0.f) & 0xffffu); }
                    }
                }
            }
    }
};

struct Epi3 {
    static constexpr int NPART = 2;
    const bf16_t* proj; bf16_t* merged;
    template <int NAI = 2, int NBJ = 2>
    __device__ __forceinline__ void mid(EPI_ARGS) const {
        unsigned lo_ = (unsigned)((wr * 64 + fr) * PLD + wc * 32 + 8 * fq) * 2u; asm volatile("" : "+v"(lo_));
        const char* pb = (const char*)proj + (((size_t)u.pm * 256 + u.ra) * PLD + u.pn * 256 + u.cb) * 2;
#pragma unroll
        for (int ai = 0; ai < NAI; ++ai)
#pragma unroll
            for (int m = 0; m < 4; ++m) {
#pragma unroll
                for (int bj = 0; bj < NBJ; ++bj) {
                    const unsigned off = lo_ + (unsigned)(((ai * 128 + m * 16) * PLD + bj * 128) * 2);
                    const u32x4 rv = *(const u32x4*)(pb + off + PC_GA * 2);
                    acc[ai][bj][m][0][0] *= bflo(rv[0]); acc[ai][bj][m][0][1] *= bfhi(rv[0]); acc[ai][bj][m][0][2] *= bflo(rv[1]); acc[ai][bj][m][0][3] *= bfhi(rv[1]);
                    acc[ai][bj][m][1][0] *= bflo(rv[2]); acc[ai][bj][m][1][1] *= bfhi(rv[2]); acc[ai][bj][m][1][2] *= bflo(rv[3]); acc[ai][bj][m][1][3] *= bfhi(rv[3]);
                    asm volatile("" : "+v"(acc[ai][bj][m][0]), "+v"(acc[ai][bj][m][1]) :: "memory");
                }
            }
    }
    template <int NAI = 2, int NBJ = 2>
    __device__ __forceinline__ void operator()(EPI_ARGS) const {
        unsigned lo_ = (unsigned)((wr * 64 + fr) * PLD + wc * 32 + 8 * fq) * 2u; asm volatile("" : "+v"(lo_));
        unsigned mo_ = (unsigned)((wr * 64 + fr) * DM + wc * 32 + 8 * fq) * 2u; asm volatile("" : "+v"(mo_));
        const char* pb = (const char*)proj + (((size_t)u.pm * 256 + u.ra) * PLD + u.pn * 256 + u.cb) * 2;
        char* mb = (char*)merged + (((size_t)u.pm * 256 + u.ra) * DM + u.pn * 256 + u.cb) * 2;
#pragma unroll
        for (int ai = 0; ai < NAI; ++ai)
#pragma unroll
            for (int m = 0; m < 4; ++m) {
#pragma unroll
                for (int bj = 0; bj < NBJ; ++bj) {
                    const unsigned off = lo_ + (unsigned)(((ai * 128 + m * 16) * PLD + bj * 128) * 2);
                    const u32x4 gb = *(const u32x4*)(pb + off + PC_GB * 2);
                    f32x4 v0 = acc[ai][bj][m][0], v1 = acc[ai][bj][m][1];
                    v0[0] *= bflo(gb[0]); v0[1] *= bfhi(gb[0]); v0[2] *= bflo(gb[1]); v0[3] *= bfhi(gb[1]);
                    v1[0] *= bflo(gb[2]); v1[1] *= bfhi(gb[2]); v1[2] *= bflo(gb[3]); v1[3] *= bfhi(gb[3]);
                    store_bf8((bf16_t*)(mb + mo_ + (unsigned)(((ai * 128 + m * 16) * DM + bj * 128) * 2)), v0, v1);
                }
                asm volatile("" ::: "memory");
            }
    }
};

struct Epi4 {
    static constexpr int NPART = 1;
    const bf16_t* xb; bf16_t* hb; float* rowss;
    template <int NAI = 2, int NBJ = 2>
    __device__ __forceinline__ void operator()(EPI_ARGS) const {
        const int col0 = u.pn * 256 + u.cb + wc * 32 + 8 * fq;
#pragma unroll
        for (int ai = 0; ai < NAI; ++ai)
#pragma unroll
            for (int m = 0; m < 4; ++m) {
                const int row = u.pm * 256 + u.ra + ai * 128 + wr * 64 + m * 16 + fr;
                float ss = 0.f;
#pragma unroll
                for (int bj = 0; bj < NBJ; ++bj) {
                    const int col = col0 + bj * 128;
                    const u32x4 xv = *(const u32x4*)(xb + (size_t)row * DM + col);
                    f32x4 h0 = acc[ai][bj][m][0], h1 = acc[ai][bj][m][1];
                    h0[0] += bflo(xv[0]); h0[1] += bfhi(xv[0]); h0[2] += bflo(xv[1]); h0[3] += bfhi(xv[1]);
                    h1[0] += bflo(xv[2]); h1[1] += bfhi(xv[2]); h1[2] += bflo(xv[3]); h1[3] += bfhi(xv[3]);
                    store_bf8(hb + (size_t)row * DM + col, h0, h1);
                    ss += (h0[0] * h0[0] + h0[1] * h0[1]) + (h0[2] * h0[2] + h0[3] * h0[3]) + (h1[0] * h1[0] + h1[1] * h1[1]) + (h1[2] * h1[2] + h1[3] * h1[3]);
                }
                ss += __shfl_xor(ss, 16); ss += __shfl_xor(ss, 32);
                if (fq == 0) atomicAdd(rowss + row, ss);
            }
    }
};

struct Epi5 {
    static constexpr int NPART = 1;
    const float* rowss; const float* cw; const float* st_in; bf16_t* act; float* th; float* out; LAS unsigned char* xb;
    __device__ __forceinline__ void operator()(EPI_ARGS) const {
        const int pm = u.pm, pn = u.pn; const bool samp = pm >= 64;
        const int cl = wc * 32 + 8 * fq, ch0 = pn * 128 + cl;
        LAS float* cwl = (LAS float*)(xb + 8192);
        const int ct_ = threadIdx.x;
        const float cw0 = cw[(size_t)(ct_ >> 8) * (2 * DFF) + ((ct_ >> 7) & 1) * DFF + pn * 128 + (ct_ & 127)];
        const float cw1 = (ct_ < 256) ? cw[(size_t)2 * (2 * DFF) + ((ct_ >> 7) & 1) * DFF + pn * 128 + (ct_ & 127)] : 0.f;
#pragma unroll
        for (int ai = 0; ai < 2; ++ai) {
            const int blk = 2 * ai + wr, R0 = pm * 256 + ai * 128 + wr * 64;
#pragma unroll
            for (int m = 0; m < 4; ++m) {
                const float rs = __builtin_amdgcn_rsqf(rowss[R0 + 16 * m + fr] * (1.0f / DM) + EPS);
#pragma unroll
                for (int bj = 0; bj < 2; ++bj)
#pragma unroll
                    for (int n = 0; n < 2; ++n) acc[ai][bj][m][n] *= rs;
            }
            if (fr >= 14) {
                const int tr = fr - 14;
#pragma unroll
                for (int bj = 0; bj < 2; ++bj)
#pragma unroll
                    for (int n = 0; n < 2; ++n) {
                        const f32x4 v = acc[ai][bj][3][n]; const int gc = bj * DFF + ch0 + 4 * n;
                        *(LAS f32x4*)(xb + ((blk * 2 + tr) * 256 + bj * 128 + cl + 4 * n) * 4) = v;
                        if (samp) { const int b = (pm - 64) * 4 + blk; *(f32x4*)(out + O_CFS + (size_t)(b * 2 + tr) * (2 * DFF) + gc) = v; }
                        else if (blk == 3) {
                            *(f32x4*)(th + (size_t)(pm * 4 + 2 + tr) * (2 * DFF) + gc) = v;
                            if ((pm & 15) == 15) *(f32x4*)(out + O_CFP + (size_t)((pm >> 4) * 2 + tr) * (2 * DFF) + gc) = v;
                        }
                    }
            }
            if (!samp && blk == 0 && fr < 2) {
#pragma unroll
                for (int bj = 0; bj < 2; ++bj)
#pragma unroll
                    for (int n = 0; n < 2; ++n) *(f32x4*)(th + (size_t)(pm * 4 + fr) * (2 * DFF) + bj * DFF + ch0 + 4 * n) = acc[ai][bj][0][n];
            }
        }
        cwl[ct_] = cw0; if (ct_ < 256) cwl[512 + ct_] = cw1;
        asm volatile("s_waitcnt lgkmcnt(0)" ::: "memory"); __builtin_amdgcn_s_barrier(); asm volatile("" ::: "memory");
#pragma unroll
        for (int ai = 0; ai < 2; ++ai) {
            const int blk = 2 * ai + wr, R0 = pm * 256 + ai * 128 + wr * 64;
#pragma unroll
            for (int n = 0; n < 2; ++n) {
                f32x4 w[3][2], P[2];
#pragma unroll
                for (int j = 0; j < 3; ++j)
#pragma unroll
                    for (int bj = 0; bj < 2; ++bj) w[j][bj] = *(const LAS f32x4*)(cwl + (j * 2 + bj) * 128 + cl + 4 * n);
#pragma unroll
                for (int bj = 0; bj < 2; ++bj) P[bj] = (f32x4){0.f, 0.f, 0.f, 0.f};
                if (fr >= 14) {
                    const int tr = fr - 14;
                    if (samp) {
                        const int b = (pm - 64) * 4 + blk;
#pragma unroll
                        for (int bj = 0; bj < 2; ++bj) P[bj] = *(const f32x4*)(st_in + (size_t)(b * 2 + tr) * (2 * DFF) + bj * DFF + ch0 + 4 * n);
                    } else if (blk > 0) {
#pragma unroll
                        for (int bj = 0; bj < 2; ++bj) P[bj] = *(const LAS f32x4*)(xb + (((blk - 1) * 2 + tr) * 256 + bj * 128 + cl + 4 * n) * 4);
                    }
                }
#pragma unroll
                for (int m = 0; m < 4; ++m) {
                    const int row = R0 + 16 * m + fr;
                    f32x4 yv[2];
#pragma unroll
                    for (int bj = 0; bj < 2; ++bj)
#pragma unroll
                        for (int e = 0; e < 4; ++e) {
                            const float x = acc[ai][bj][m][n][e];
                            const float pr = (m == 0) ? P[bj][e] : acc[ai][bj][(m + 3) & 3][n][e];
                            const float x1 = dppf<0x111>(x) + dppf<0x10F>(pr);
                            const float x2 = dppf<0x112>(x) + dppf<0x10E>(pr);
                            float y_ = __builtin_fmaf(w[0][bj][e], x2, __builtin_fmaf(w[1][bj][e], x1, w[2][bj][e] * x)); asm("" : "+v"(y_));
                            yv[bj][e] = y_;
                        }
                    u32x2 o;
                    o.x = cvtpk(yv[0][0] * sigmoidf_(yv[0][0]) * yv[1][0], yv[0][1] * sigmoidf_(yv[0][1]) * yv[1][1]);
                    o.y = cvtpk(yv[0][2] * sigmoidf_(yv[0][2]) * yv[1][2], yv[0][3] * sigmoidf_(yv[0][3]) * yv[1][3]);
                    *(u32x2*)(act + (size_t)row * DFF + ch0 + 4 * n) = o;
                }
                asm volatile("" ::: "memory");
            }
        }
    }
};

struct Epi6 {
    static constexpr int NPART = 1;
    bf16_t* hb;
    template <int NAI = 2, int NBJ = 2>
    __device__ __forceinline__ void operator()(EPI_ARGS) const {
        const int col0 = u.pn * 256 + u.cb + wc * 32 + 8 * fq;
#pragma unroll
        for (int ai = 0; ai < NAI; ++ai)
#pragma unroll
            for (int m = 0; m < 4; ++m) {
                const int row = u.pm * 256 + u.ra + ai * 128 + wr * 64 + m * 16 + fr;
#pragma unroll
                for (int bj = 0; bj < NBJ; ++bj) {
                    bf16_t* p = hb + (size_t)row * DM + col0 + bj * 128;
                    const u32x4 hv = *(const u32x4*)p;
                    f32x4 h0 = acc[ai][bj][m][0], h1 = acc[ai][bj][m][1];
                    h0[0] += bflo(hv[0]); h0[1] += bfhi(hv[0]); h0[2] += bflo(hv[1]); h0[3] += bfhi(hv[1]);
                    h1[0] += bflo(hv[2]); h1[1] += bfhi(hv[2]); h1[2] += bflo(hv[3]); h1[3] += bfhi(hv[3]);
                    store_bf8(p, h0, h1);
                }
            }
    }
};

struct Epi6S {
    static constexpr int NPART = 1;
    float* scr;
    template <int NAI = 2, int NBJ = 2>
    __device__ __forceinline__ void operator()(EPI_ARGS) const {
        const int col0 = u.cb + wc * 32 + 8 * fq;
#pragma unroll
        for (int ai = 0; ai < NAI; ++ai)
#pragma unroll
            for (int m = 0; m < 4; ++m) {
                const int row = u.ra + ai * 128 + wr * 64 + m * 16 + fr;
#pragma unroll
                for (int bj = 0; bj < NBJ; ++bj) { float* p = scr + row * 256 + col0 + bj * 128; *(f32x4*)p = acc[ai][bj][m][0]; *(f32x4*)(p + 4) = acc[ai][bj][m][1]; }
            }
    }
};

__device__ __forceinline__ float wave_sum(float v) {
#pragma unroll
    for (int o = 1; o < 64; o <<= 1) v += __shfl_xor(v, o);
    return v;
}
template <int MODE>
__device__ __forceinline__ void transpose_item(const float* W, int N, bf16_t* WT, int ldt, int coff, LAS float* scr, int item, int lane, const float* g) {
    const int nblk = N / 32, kb = item / nblk, nb = item % nblk, k0 = 64 * kb, n0 = 32 * nb;
#pragma unroll 8
    for (int i = 0; i < 32; ++i) { const int kk = 2 * i + (lane >> 5); float v = W[(size_t)(k0 + kk) * N + n0 + (lane & 31)]; if (MODE >= 1) v *= g[k0 + kk]; scr[kk * 33 + (lane & 31)] = v; }
    asm volatile("s_waitcnt lgkmcnt(0)" ::: "memory");
    const int c = lane & 7;
#pragma unroll
    for (int j = 0; j < 4; ++j) {
        const int n = (lane >> 3) + 8 * j; const LAS float* s = scr + (8 * c) * 33 + n;
        u32x4 o; o.x = cvtpk(s[0 * 33], s[1 * 33]); o.y = cvtpk(s[2 * 33], s[3 * 33]); o.z = cvtpk(s[4 * 33], s[5 * 33]); o.w = cvtpk(s[6 * 33], s[7 * 33]);
        int dr = n0 + n;
        if (MODE == 1) { dr = (dr < DFF) ? 256 * (dr >> 7) + (dr & 127) : 256 * ((dr - DFF) >> 7) + 128 + ((dr - DFF) & 127); }
        if (MODE == 2) {
            if (dr >= 6144) { const int t = dr - 6144, ch = t & 2047; dr = 6144 + 256 * (ch >> 7) + ((t >> 11) << 7) + (ch & 127); }
            else if (dr >= 4096) { const int t = dr - 4096, ch = t & 1023; dr = 4096 + 256 * (ch >> 7) + ((t >> 10) << 7) + (ch & 127); }
        }
        *(u32x4*)(WT + (size_t)dr * ldt + coff + k0 + 8 * c) = o;
    }
    asm volatile("s_waitcnt lgkmcnt(0)" ::: "memory");
}

__device__ __forceinline__ int rel_bucket(int rel) {
    const int n = rel < 0 ? -rel : rel; int b;
    if (n < 8) b = n; else b = n < 12 ? 8 : n < 16 ? 9 : n < 23 ? 10 : n < 32 ? 11 : n < 46 ? 12 : n < 64 ? 13 : n < 91 ? 14 : 15;
    return (rel > 0 ? 16 : 0) + b;
}

namespace att {
constexpr int KSL = 64 * 144, KBUF = 2 * KSL, VBUF = 128 * 144, STAGE = KBUF + VBUF;
constexpr int PER_XCD = 16 + 128;
__device__ __forceinline__ int crow(int r, int hi) { return (r & 3) + 8 * (r >> 2) + 4 * hi; }

struct Ctx { const bf16_t* proj; const bf16_t* kc; const bf16_t* vtc; const bf16_t* vtp; const bf16_t* vtn; bf16_t* oob; const float* subln; float lam; };

__device__ __forceinline__ void unit(const Ctx& C, int xq, int idx, LAS unsigned char* lds) {
    bool samp; int b, h, cp;
    if (idx < 16) { samp = true; const int s_ = xq * 16 + idx; b = s_ >> 3; h = s_ & 7; cp = 8; }
    else { samp = false; const int v = idx - 16, id = xq * 4 + (v >> 5); b = id >> 3; h = id & 7; cp = 31 - (v & 31); }
    const int nt = samp ? 17 : 2 * cp + 2;
    const int tid = threadIdx.x, lane = tid & 63, wid = __builtin_amdgcn_readfirstlane(tid >> 6);
    const int q = lane & 31, hi = lane >> 5, mp = wid >> 2, rb = wid & 3;
    const int cw = samp ? 16 : 2 * cp + (rb >> 1);
    const bool valid = !samp || rb < 2;
    const int qrow = samp ? MP + b * 64 + 32 * (rb & 1) + q : b * SEQ + 128 * cp + 32 * rb + q;
    bf16x8 qf[4];
    { const bf16_t* qp = C.proj + (size_t)qrow * PLD + PC_Q + h * 128 + mp * 64 + hi * 8;
#pragma unroll
      for (int d0 = 0; d0 < 4; ++d0) qf[d0] = *(const bf16x8*)(qp + d0 * 16); }
    u32x4 krA[2], vrA[2], krB[2], vrB[2];
#define ATT_LOAD(j, kr, vr) do { const bf16_t* kp_; const bf16_t* vp_; size_t kpi_, vpi_; \
        if (!samp) { kp_ = C.proj + ((size_t)b * SEQ + 64 * (j)) * PLD + PC_K + h * 128; kpi_ = PLD; vp_ = C.vtp + ((size_t)(b * 8 + h) * 128) * SEQ + 64 * (j); vpi_ = SEQ; } \
        else if ((j) < 16) { kp_ = C.kc + ((size_t)b * PAST + 64 * (j)) * 1024 + h * 128; kpi_ = 1024; vp_ = C.vtc + ((size_t)(b * 8 + h) * 128) * PAST + 64 * (j); vpi_ = PAST; } \
        else { kp_ = C.proj + ((size_t)MP + b * 64) * PLD + PC_K + h * 128; kpi_ = PLD; vp_ = C.vtn + ((size_t)(b * 8 + h) * 128) * 64; vpi_ = 64; } \
        _Pragma("unroll") for (int i_ = 0; i_ < 2; ++i_) { const int id_ = tid + 512 * i_; \
            kr[i_] = *(const u32x4*)(kp_ + (size_t)(id_ >> 4) * kpi_ + (id_ & 15) * 8); vr[i_] = *(const u32x4*)(vp_ + (size_t)(id_ >> 3) * vpi_ + (id_ & 7) * 8); } } while (0)
#define ATT_STORE(buf, kr, vr) do { LAS unsigned char* sb_ = lds + (buf) * STAGE; \
        _Pragma("unroll") for (int i_ = 0; i_ < 2; ++i_) { const int id_ = tid + 512 * i_; \
            *(LAS u32x4*)(sb_ + ((id_ & 15) >> 3) * KSL + (id_ >> 4) * 144 + (id_ & 7) * 16) = kr[i_]; *(LAS u32x4*)(sb_ + KBUF + (id_ >> 3) * 144 + (id_ & 7) * 16) = vr[i_]; } } while (0)
    ATT_LOAD(0, krA, vrA); ATT_STORE(0, krA, vrA);
    if (nt > 1) ATT_LOAD(1, krA, vrA);
    if (nt > 2) ATT_LOAD(2, krB, vrB);
    __syncthreads();
    const int pi = 16 * (q >> 4) + 8 * ((q >> 2) & 1) + 4 * ((q >> 3) & 1) + (q & 3);
    const int koff = mp * KSL + pi * 144 + hi * 16;
    const int voff = KBUF + q * 144 + hi * 16;
    const LAS float* tab = (const LAS float*)(lds + TAB_OFF) + h * 256;
    const float b15 = tab[0];
    constexpr float C2 = 0.125f * LOG2E;
    f32x16 O[4];
#pragma unroll
    for (int i = 0; i < 4; ++i)
#pragma unroll
        for (int r = 0; r < 16; ++r) O[i][r] = 0.f;
    float mrun = -1e30f, lrun = 0.f;
    auto tile = [&](const LAS unsigned char* sb, int j) __attribute__((always_inline)) {

        f32x16 S0, S1;
#pragma unroll
        for (int r = 0; r < 16; ++r) { S0[r] = 0.f; S1[r] = 0.f; }
#pragma unroll
        for (int d0 = 0; d0 < 4; ++d0) {
            const bf16x8 a0 = *(const LAS bf16x8*)(sb + koff + d0 * 32), a1 = *(const LAS bf16x8*)(sb + koff + 32 * 144 + d0 * 32);
            S0 = __builtin_amdgcn_mfma_f32_32x32x16_bf16(a0, qf[d0], S0, 0, 0, 0);
            S1 = __builtin_amdgcn_mfma_f32_32x32x16_bf16(a1, qf[d0], S1, 0, 0, 0);
        }
        if (j + 3 <= cw) {
#pragma unroll
            for (int r = 0; r < 16; ++r) { float a_ = __builtin_fmaf(S0[r], C2, b15), b_ = __builtin_fmaf(S1[r], C2, b15); asm("" : "+v"(a_)); asm("" : "+v"(b_)); S0[r] = a_; S1[r] = b_; }
        } else {
            const LAS float* tb = tab + (64 * (j - cw) + 8 * hi - 32 * (rb & 1) - q + 191);
#pragma unroll
            for (int r = 0; r < 16; ++r) { S0[r] = S0[r] * C2 + tb[16 * (r >> 3) + (r & 7)]; S1[r] = S1[r] * C2 + tb[32 + 16 * (r >> 3) + (r & 7)]; }
        }
        float rm = __builtin_fmaxf(__builtin_fmaxf(S0[0], S1[0]), S0[1]);
        rm = __builtin_fmaxf(__builtin_fmaxf(rm, S1[1]), S0[2]); rm = __builtin_fmaxf(__builtin_fmaxf(rm, S1[2]), S0[3]);
#pragma unroll
        for (int r = 3; r < 15; r += 2) { rm = __builtin_fmaxf(__builtin_fmaxf(rm, S1[r]), S0[r + 1]); rm = __builtin_fmaxf(__builtin_fmaxf(rm, S1[r + 1]), S0[r + 2]); }
        rm = __builtin_fmaxf(rm, S1[15]);
        { float ra = rm, rbv = rm; swap32(ra, rbv); rm = __builtin_fmaxf(ra, rbv); }
        if (__any(rm > mrun + 8.f)) {
            const float mn = __builtin_fmaxf(mrun, rm), al = __builtin_amdgcn_exp2f(mrun - mn);
            mrun = mn; lrun *= al;
#pragma unroll
            for (int i = 0; i < 4; ++i)
#pragma unroll
                for (int r = 0; r < 16; ++r) O[i][r] *= al;
        }
        float ls0 = 0.f, ls1 = 0.f;
#pragma unroll
        for (int r = 0; r < 16; ++r) {
            float a_ = __builtin_amdgcn_exp2f(S0[r] - mrun), b_ = __builtin_amdgcn_exp2f(S1[r] - mrun);
            S0[r] = a_; S1[r] = b_; ls0 += a_; asm("" : "+v"(ls0)); ls1 += b_; asm("" : "+v"(ls1));
        }
        lrun += ls0 + ls1;
        bf16x8 pb[4];
#pragma unroll
        for (int mm = 0; mm < 2; ++mm) {
            u32x4 w0, w1;
            w0.x = cvtpk(S0[8 * mm + 0], S0[8 * mm + 1]); w0.y = cvtpk(S0[8 * mm + 2], S0[8 * mm + 3]); w0.z = cvtpk(S0[8 * mm + 4], S0[8 * mm + 5]); w0.w = cvtpk(S0[8 * mm + 6], S0[8 * mm + 7]);
            w1.x = cvtpk(S1[8 * mm + 0], S1[8 * mm + 1]); w1.y = cvtpk(S1[8 * mm + 2], S1[8 * mm + 3]); w1.z = cvtpk(S1[8 * mm + 4], S1[8 * mm + 5]); w1.w = cvtpk(S1[8 * mm + 6], S1[8 * mm + 7]);
            pb[mm] = __builtin_bit_cast(bf16x8, w0); pb[2 + mm] = __builtin_bit_cast(bf16x8, w1);
        }
#pragma unroll
        for (int kk = 0; kk < 4; ++kk)
#pragma unroll
            for (int i = 0; i < 4; ++i) {
                const bf16x8 av = *(const LAS bf16x8*)(sb + voff + i * 32 * 144 + kk * 32);
                O[i] = __builtin_amdgcn_mfma_f32_32x32x16_bf16(av, pb[kk], O[i], 0, 0, 0);
            }
    };
    for (int j = 0; j < nt; j += 2) {
        if (valid && j <= cw) tile(lds, j);
        if (j + 1 < nt) ATT_STORE(1, krA, vrA);
        if (j + 3 < nt) ATT_LOAD(j + 3, krA, vrA);
        __syncthreads();
        if (j + 1 >= nt) break;
        if (valid && j + 1 <= cw) tile(lds + STAGE, j + 1);
        if (j + 2 < nt) ATT_STORE(0, krB, vrB);
        if (j + 4 < nt) ATT_LOAD(j + 4, krB, vrB);
        __syncthreads();
    }
#undef ATT_LOAD
#undef ATT_STORE
    { float ra = lrun, rbv = lrun; swap32(ra, rbv); lrun = ra + rbv; }
    const float inv = 1.0f / lrun;
    LAS float* X = (LAS float*)lds + rb * 4096;
    if (mp == 1 && valid) {
#pragma unroll
        for (int i = 0; i < 4; ++i)
#pragma unroll
            for (int r = 0; r < 16; ++r) X[(32 * i + crow(r, hi)) * 32 + q] = O[i][r] * inv;
    }
    __syncthreads();
    if (mp == 0 && valid) {
        float ss = 0.f;
#pragma unroll
        for (int i = 0; i < 4; ++i)
#pragma unroll
            for (int r = 0; r < 16; ++r) { const float o = O[i][r] * inv - C.lam * X[(32 * i + crow(r, hi)) * 32 + q]; O[i][r] = o; ss += o * o; }
        { float ra = ss, rbv = ss; swap32(ra, rbv); ss = ra + rbv; }
        const float rn = __builtin_amdgcn_rsqf(ss * (1.0f / DV) + EPS) * 0.8f;
        bf16_t* op = C.oob + (size_t)qrow * DM + h * 128;
#pragma unroll
        for (int i = 0; i < 4; ++i)
#pragma unroll
            for (int g4 = 0; g4 < 4; ++g4) {
                const int dv0 = 32 * i + 8 * g4 + 4 * hi; const f32x4 sg = *(const f32x4*)(C.subln + dv0);
                u32x2 w; w.x = cvtpk(O[i][4 * g4 + 0] * rn * sg[0], O[i][4 * g4 + 1] * rn * sg[1]); w.y = cvtpk(O[i][4 * g4 + 2] * rn * sg[2], O[i][4 * g4 + 3] * rn * sg[3]);
                *(u32x2*)(op + dv0) = w;
            }
    }
    __syncthreads();
}
}

#define RLX_AGENT __ATOMIC_RELAXED, __HIP_MEMORY_SCOPE_AGENT
#define XB_TMO      128
#define XB_XCNT(j)  (256  + 64 * (j))
#define XB_XSUB(j)  (1280 + 64 * (j))
#define XB_XGEN(j)  (2304 + 64 * (j))
#define XB_TOP      3328
#define XB_TOPGEN   3392
#define XCD_BAR_WORDS 3456
#define XB_SPIN_CAP (1u << 18)

__device__ __forceinline__ unsigned xb_ld(unsigned* p)              { return __hip_atomic_load(p, __ATOMIC_RELAXED, __HIP_MEMORY_SCOPE_AGENT); }
__device__ __forceinline__ unsigned xb_add(unsigned* p, unsigned v) { return __hip_atomic_fetch_add(p, v, __ATOMIC_RELAXED, __HIP_MEMORY_SCOPE_AGENT); }
__device__ __forceinline__ unsigned xb_xcc_id() { return (unsigned)__builtin_amdgcn_s_getreg((3 << 11) | 20) & 0xFu; }
#define XB_SPIN(cond, bar) do { unsigned _sp = 0; while (cond) { __builtin_amdgcn_s_sleep(1); \
    if ((++_sp & 255u) == 0u) { if (xb_ld(&(bar)[XB_TMO])) break; if (_sp > XB_SPIN_CAP) { atomicAdd(&(bar)[XB_TMO], 1u); break; } } } } while (0)

struct XcdBarrier {
    unsigned* bar; unsigned x;
    volatile LAS unsigned* st;
};

__device__ __forceinline__ XcdBarrier xcd_barrier_post(unsigned* bar, volatile LAS unsigned* st) {
    XcdBarrier b; b.bar = bar; b.x = xb_xcc_id(); b.st = st;
    if (threadIdx.x == 0) (void)xb_add(&bar[XB_XCNT(b.x)], 1u);
    return b;
}
__device__ __forceinline__ void xcd_barrier_complete(unsigned* bar, unsigned x, unsigned& nloc, unsigned& nx) {
    const unsigned G = gridDim.x * gridDim.y * gridDim.z;
    unsigned sum, cnt, mine, sp = 0u;
    for (;;) {
        sum = 0u; cnt = 0u; mine = 0u;
#pragma unroll
        for (unsigned j = 0; j < 16; ++j) { const unsigned c = xb_ld(&bar[XB_XCNT(j)]); sum += c; cnt += (c > 0u) ? 1u : 0u; mine = (j == x) ? c : mine; }
        if (sum == G) break;
        __builtin_amdgcn_s_sleep(1);
        if ((++sp & 255u) == 0u) { if (xb_ld(&bar[XB_TMO])) break; if (sp > XB_SPIN_CAP) { atomicAdd(&bar[XB_TMO], 1u); break; } }
    }
    nloc = mine > 0u ? mine : 1u; nx = cnt > 0u ? cnt : 1u;
}

__device__ __forceinline__ void xcd_barrier(const XcdBarrier& b) {
    asm volatile("s_waitcnt vmcnt(0)" ::: "memory");
    __syncthreads();
    if (threadIdx.x == 0) {
        unsigned* bar = b.bar;
        __builtin_amdgcn_s_waitcnt(0);
        unsigned nloc = b.st[0], nx = b.st[1];
        if (nloc == 0u) { xcd_barrier_complete(bar, b.x, nloc, nx); b.st[0] = nloc; b.st[1] = nx; }
        const unsigned old = xb_add(&bar[XB_XSUB(b.x)], 1u);
        const unsigned gen = old / nloc;
        if (old + 1u == (gen + 1u) * nloc) {
            __builtin_amdgcn_fence(__ATOMIC_RELEASE, "agent");
            asm volatile("s_waitcnt vmcnt(0)" ::: "memory");
            const unsigned og = xb_add(&bar[XB_TOP], 1u);
            const unsigned tg = og / nx;
            if (og + 1u == (tg + 1u) * nx) xb_add(&bar[XB_TOPGEN], 1u);
            else XB_SPIN(xb_ld(&bar[XB_TOPGEN]) == tg, bar);
            __builtin_amdgcn_fence(__ATOMIC_ACQUIRE, "agent");
            xb_add(&bar[XB_XGEN(b.x)], 1u);
            asm volatile("s_waitcnt vmcnt(0)" ::: "memory");
        } else {
            XB_SPIN(xb_ld(&bar[XB_XGEN(b.x)]) == gen, bar);
            __builtin_amdgcn_fence(__ATOMIC_ACQUIRE, "agent");
            asm volatile("s_waitcnt vmcnt(0)" ::: "memory");
        }
    }
    __syncthreads();
}


struct Args { const float* in[23]; float* out; unsigned char* ws; int ph_lo, ph_hi; };
enum { I_XP = 0, I_XS, I_CK, I_CV, I_SCM, I_SCF, I_RB, I_N1, I_WIN, I_LQ1, I_LK1, I_LQ2, I_LK2, I_SUB, I_CW, I_WA, I_WB, I_WO, I_N2, I_WUP, I_FCW, I_WDN, I_FG };
constexpr int NPH = 9;

__global__ void __launch_bounds__(512, 2) mk_fwd(Args a) {
    extern __shared__ __attribute__((aligned(16))) unsigned char lds_raw[];
    LAS unsigned char* lds = (LAS unsigned char*)lds_raw;
    const int tid = threadIdx.x, lane = tid & 63, wave = __builtin_amdgcn_readfirstlane(tid >> 6);
    const int G = gridDim.x, bx = blockIdx.x;
    const int gw = bx * 8 + wave, NGW = G * 8;
    unsigned char* ws = a.ws; float* out = a.out;
    unsigned* ctl = (unsigned*)(ws + WS_CTL); float* rowss = (float*)(ws + WS_ROWSS);
    bf16_t* WIN = (bf16_t*)(ws + WS_WIN); bf16_t* WAB = (bf16_t*)(ws + WS_WAB); bf16_t* WO = (bf16_t*)(ws + WS_WO);
    bf16_t* PROJ = (bf16_t*)(ws + WS_PROJ); bf16_t* KC = (bf16_t*)(ws + WS_KC); bf16_t* VTC = (bf16_t*)(ws + WS_VTC);
    bf16_t* VTP = (bf16_t*)(ws + WS_VTP); bf16_t* VTN = (bf16_t*)(ws + WS_VTN); bf16_t* MERGED = (bf16_t*)(ws + WS_MERGED);
    bf16_t* WUP = (bf16_t*)(ws + WS_WUP); bf16_t* WDN = (bf16_t*)(ws + WS_WDN); bf16_t* HB = (bf16_t*)(ws + WS_HB);
    bf16_t* ACT = (bf16_t*)(ws + WS_ACT); float* TH = (float*)(ws + WS_TH);
    bf16_t* XB = (bf16_t*)(out + O_Y) + (size_t)MTOT * DM;
    bf16_t* OOB = (bf16_t*)(out + O_Y); float* rstd1 = (float*)(ws + WS_RSTD1);
    const int lo = a.ph_lo, hi_ = a.ph_hi;
#ifndef PH_MASK
#define PH_MASK 0x1ff
#endif
#define IN(k) (((PH_MASK >> (k)) & 1) && lo <= (k) && (k) < hi_)
    const int QLIM = (G == 256) ? 512 : 0x7fffffff;
#define QUARTERS(EPI) if (G == 256 && bx < 128) { Unit qu; S.unit_of(512 + (bx >> 2), qu); qu.ra = ((bx >> 1) & 1) * 128; qu.cb = (bx & 1) * 128; pg8::gemm_quarter<EPI>(lds, g, qu, E); }
    volatile LAS unsigned* bst = (volatile LAS unsigned*)(lds + MISC_OFF + 32);
    if (tid < 2) bst[tid] = 0u;
    __syncthreads();
    XcdBarrier xbar = xcd_barrier_post(ctl + 4096, bst);
    if (a.ph_hi > NPH) cg::this_grid().sync();
#define SEAM(k) do { if (IN(k) && IN((k) + 1)) xcd_barrier(xbar); } while (0)
    LAS float* scr = (LAS float*)(lds + wave * 16384);

    for (int rep_ = 0; rep_ < (PROBE_DUP == 100 ? 2 : 1); ++rep_)
    if (IN(0)) {
        constexpr int I_IN = 32 * 320, I_A = 16 * 64, I_O = 32 * 64, I_V = 16 * 32;
        constexpr int NIT = I_IN + 2 * I_A + I_O + 16 * I_V;
        for (int it = gw; it < NIT; it += NGW) {
            int r = it;
            if (r < I_IN) { transpose_item<2>(a.in[I_WIN], NIN, WIN, DM, 0, scr, r, lane, a.in[I_N1]); continue; } r -= I_IN;
            if (r < I_A) { transpose_item<0>(a.in[I_WA], DM, WAB, 2048, 0, scr, r, lane, nullptr); continue; } r -= I_A;
            if (r < I_A) { transpose_item<0>(a.in[I_WB], DM, WAB, 2048, 1024, scr, r, lane, nullptr); continue; } r -= I_A;
            if (r < I_O) { transpose_item<0>(a.in[I_WO], DM, WO, DM, 0, scr, r, lane, nullptr); continue; } r -= I_O;
            { const int bb = r / I_V; transpose_item<0>(a.in[I_CV] + (size_t)bb * PAST * 1024, 1024, VTC + (size_t)bb * 1024 * PAST, PAST, 0, scr, r % I_V, lane, nullptr); }
        }
        for (int m = gw; m < MTOT; m += NGW) {
            const float* xr = (m < MP) ? a.in[I_XP] + (size_t)m * DM : a.in[I_XS] + (size_t)(m - MP) * DM;
            f32x4 v[8]; float s = 0.f;
#pragma unroll
            for (int j = 0; j < 8; ++j) { v[j] = *(const f32x4*)(xr + 4 * lane + 256 * j); s += (v[j][0] * v[j][0] + v[j][1] * v[j][1]) + (v[j][2] * v[j][2] + v[j][3] * v[j][3]); }
            const float rstd = __builtin_amdgcn_rsqf(wave_sum(s) * (1.0f / DM) + EPS);
            if (lane == 0) rstd1[m] = rstd;
#pragma unroll
            for (int j = 0; j < 8; ++j) { u32x2 w; w.x = cvtpk(v[j][0], v[j][1]); w.y = cvtpk(v[j][2], v[j][3]);
                *(u32x2*)(XB + (size_t)m * DM + 4 * lane + 256 * j) = w; }
        }
        for (size_t i = (size_t)gw; i < (size_t)DBATCH * PAST * 1024 / 512; i += NGW) {
            const float* s = a.in[I_CK] + i * 512 + lane * 8; const f32x4 v0 = *(const f32x4*)s, v1 = *(const f32x4*)(s + 4);
            store_bf8(KC + i * 512 + lane * 8, v0, v1);
        }
    }
    SEAM(0);
    if (IN(1)) {
        pg8::Gemm g{XB, WIN, DM, DM, DM}; pg8::StaticOrder S; S.init(MTOT / 256, NIN / 256, G, bx);
        Epi1 E{PROJ, out, VTP, VTN, rstd1};
        pg8::gemm_phase<Epi1>(lds, g, S, E);
    }
    SEAM(1);
    if (IN(2)) {
        for (int i = tid; i < 8 * 256; i += 512) { const int hh = i >> 8, rel = (i & 255) - 191; ((LAS float*)(lds + TAB_OFF))[i] = a.in[I_RB][rel_bucket(rel) * NH + hh] * LOG2E; }
        float d1 = 0.f, d2 = 0.f;
        for (int i = 0; i < 64; ++i) { d1 += a.in[I_LQ1][i] * a.in[I_LK1][i]; d2 += a.in[I_LQ2][i] * a.in[I_LK2][i]; }
        att::Ctx C{PROJ, KC, VTC, VTP, VTN, OOB, a.in[I_SUB], __expf(d1) - __expf(d2) + 0.2f};
        LAS int* misc = (LAS int*)(lds + MISC_OFF);
        __syncthreads();
        for (int rep_ = 0; rep_ < (PROBE_DUP == 2 ? 2 : 1); ++rep_)
        for (int qi = 0; qi < 8; ++qi) {
            const int xq = (bx + qi) & 7;
            for (;;) {
                if (tid == 0) misc[0] = (int)atomicAdd(ctl + 64 * (xq + 8 * rep_), 1u);
                __syncthreads();
                const int idx = misc[0];
                __syncthreads();
                if (idx >= att::PER_XCD) break;
                att::unit(C, xq, idx, lds);
            }
        }
        const float* cwm = a.in[I_CW];
        for (int it = bx * 512 + tid; it < (MTOT / 8) * 128; it += G * 512) {
            const int cg8 = it & 127, r0 = (it >> 7) * 8, ch = cg8 * 8;
            const bool samp = r0 >= MP; const int t0 = samp ? ((r0 - MP) & 63) : (r0 & (SEQ - 1));
            float w0[8], w1[8], w2[8], u1[8], u2[8];
#pragma unroll
            for (int e = 0; e < 8; ++e) { w0[e] = cwm[ch + e]; w1[e] = cwm[1024 + ch + e]; w2[e] = cwm[2048 + ch + e]; }
            if (t0 == 0) {
                if (samp) { const float* st = a.in[I_SCM] + (size_t)((r0 - MP) >> 6) * 2048 + ch;
#pragma unroll
                    for (int e = 0; e < 8; ++e) { u2[e] = st[e]; u1[e] = st[1024 + e]; } }
                else {
#pragma unroll
                    for (int e = 0; e < 8; ++e) { u2[e] = 0.f; u1[e] = 0.f; } }
            } else {
                const bf16_t* p2 = PROJ + (size_t)(r0 - 2) * PLD + ch; const bf16_t* p1 = p2 + PLD;
                const u32x4 c2 = *(const u32x4*)(p2 + PC_C), c1 = *(const u32x4*)(p1 + PC_C);
#pragma unroll
                for (int w = 0; w < 4; ++w) { u2[2 * w] = bflo(c2[w]); u2[2 * w + 1] = bfhi(c2[w]); u1[2 * w] = bflo(c1[w]); u1[2 * w + 1] = bfhi(c1[w]); }
            }
#pragma unroll
            for (int rr = 0; rr < 8; ++rr) {
                const int row = r0 + rr; const bf16_t* p = PROJ + (size_t)row * PLD + ch;
                const u32x4 cc = *(const u32x4*)(p + PC_C), bb = *(const u32x4*)(p + PC_B);
                float uu[8], ob[8];
#pragma unroll
                for (int w = 0; w < 4; ++w) { uu[2 * w] = bflo(cc[w]); uu[2 * w + 1] = bfhi(cc[w]); }
#pragma unroll
                for (int w = 0; w < 4; ++w) {
                    ob[2 * w] = bflo(bb[w]) * (w0[2 * w] * u2[2 * w] + w1[2 * w] * u1[2 * w] + w2[2 * w] * uu[2 * w]);
                    ob[2 * w + 1] = bfhi(bb[w]) * (w0[2 * w + 1] * u2[2 * w + 1] + w1[2 * w + 1] * u1[2 * w + 1] + w2[2 * w + 1] * uu[2 * w + 1]);
                }
                u32x4 o; o.x = cvtpk(ob[0], ob[1]); o.y = cvtpk(ob[2], ob[3]); o.z = cvtpk(ob[4], ob[5]); o.w = cvtpk(ob[6], ob[7]);
                *(u32x4*)(OOB + (size_t)row * DM + 1024 + ch) = o;
                const int t = t0 + rr;
                if (samp ? (t >= DSEQ - 2) : (t >= SEQ - 2)) {
                    float* so = samp ? out + O_CMS + (size_t)(((row - MP) >> 6) * 2 + (t - (DSEQ - 2))) * 1024 + ch : out + O_CMP + (size_t)((row >> 12) * 2 + (t - (SEQ - 2))) * 1024 + ch;
                    *(f32x4*)so = (f32x4){uu[0], uu[1], uu[2], uu[3]}; *(f32x4*)(so + 4) = (f32x4){uu[4], uu[5], uu[6], uu[7]};
                }
#pragma unroll
                for (int e = 0; e < 8; ++e) { u2[e] = u1[e]; u1[e] = uu[e]; }
            }
        }
    }
    SEAM(2);
    if (IN(3)) {
        constexpr int I_U = 32 * 352, I_D = 88 * 64;
        for (int it = gw; it < I_U + I_D; it += NGW) {
            if (it < I_U) transpose_item<1>(a.in[I_WUP], 2 * DFF, WUP, DM, 0, scr, it, lane, a.in[I_N2]);
            else transpose_item<0>(a.in[I_WDN], DM, WDN, DFF, 0, scr, it - I_U, lane, nullptr);
        }
        __syncthreads();
        pg8::Gemm g{OOB, WAB, DM, DM, 1024}; pg8::StaticOrder S; S.init(MTOT / 256, DM / 256, G, bx, QLIM);
        Epi3 E{PROJ, MERGED};
        QUARTERS(Epi3)
        pg8::gemm_phase<Epi3>(lds, g, S, E);
    }
    SEAM(3);
    if (IN(4)) {
        pg8::Gemm g{MERGED, WO, DM, DM, DM}; pg8::StaticOrder S; S.init(MTOT / 256, DM / 256, G, bx, QLIM);
        Epi4 E{XB, HB, rowss};
        QUARTERS(Epi4)
        pg8::gemm_phase<Epi4>(lds, g, S, E);
    }
    SEAM(4);
    if (IN(5)) {
        pg8::Gemm g{HB, WUP, DM, DM, DM}; pg8::StaticOrder S; S.init(MTOT / 256, (2 * DFF) / 256, G, bx);
        Epi5 E{rowss, a.in[I_FCW], a.in[I_SCF], ACT, TH, out, lds + XB_OFF};
        pg8::gemm_phase<Epi5>(lds, g, S, E);
    }
    SEAM(5);
    if (IN(6)) {
        const float* cw = a.in[I_FCW];
        for (int it = bx * 512 + tid; it < 64 * DFF; it += G * 512) {
            const int pm = it / DFF, ch = it - pm * DFF;
            if ((pm & 15) == 0) continue;
            float yv[2][2];
#pragma unroll
            for (int bj = 0; bj < 2; ++bj) {
                const int gc = bj * DFF + ch;
                const float t2 = TH[(size_t)((pm - 1) * 4 + 2) * (2 * DFF) + gc], t3 = TH[(size_t)((pm - 1) * 4 + 3) * (2 * DFF) + gc];
                const float h0 = TH[(size_t)(pm * 4 + 0) * (2 * DFF) + gc], h1 = TH[(size_t)(pm * 4 + 1) * (2 * DFF) + gc];
                const float w0 = cw[gc], w1 = cw[2 * DFF + gc], w2 = cw[4 * DFF + gc];
                yv[bj][0] = w0 * t2 + w1 * t3 + w2 * h0; yv[bj][1] = w0 * t3 + w1 * h0 + w2 * h1;
            }
#pragma unroll
            for (int r = 0; r < 2; ++r) ACT[(size_t)(pm * 256 + r) * DFF + ch] = (bf16_t)(cvtpk(yv[0][r] * sigmoidf_(yv[0][r]) * yv[1][r], 0.f) & 0xffffu);
        }
    }
    SEAM(6);
    if (IN(7)) {
        pg8::Gemm g{ACT, WDN, DFF, DFF, DFF}; pg8::StaticOrder S; S.init(MTOT / 256, DM / 256, G, bx, QLIM);
        Epi6 E{HB};
        if (G == 256) {
            const int qi = bx >> 1, kh = bx & 1;
            Unit qu; S.unit_of(512 + (qi >> 2), qu); qu.ra = ((qi >> 1) & 1) * 128; qu.cb = (qi & 1) * 128;
            pg8::Gemm g2{ACT + kh * (DFF / 2), WDN + kh * (DFF / 2), DFF, DFF, DFF / 2};
            Epi6S E2{(float*)(ws + WS_SCR6) + ((size_t)kh * 32 + (qi >> 2)) * 65536};
            pg8::gemm_quarter<Epi6S>(lds, g2, qu, E2);
        }
        pg8::gemm_phase<Epi6>(lds, g, S, E);
    }
    SEAM(7);
    if (IN(8)) {
        LAS int* tabq = (LAS int*)lds;
        for (int i = tid; i < 68 * 8; i += 512) tabq[i] = -1;
        __syncthreads();
        if (G == 256 && tid < 32) { pg8::StaticOrder S; S.init(MTOT / 256, DM / 256, G, bx, QLIM); Unit qu; S.unit_of(512 + tid, qu); tabq[qu.pm * 8 + qu.pn] = tid; }
        __syncthreads();
        const float* scr6 = (const float*)(ws + WS_SCR6);
        for (int m = gw; m < MTOT; m += NGW) {
            const bf16_t* hr = HB + (size_t)m * DM; float* yr = out + O_Y + (size_t)m * DM;
            f32x4 v[4][2]; float s2 = 0.f;
#pragma unroll
            for (int j = 0; j < 4; ++j) {
                const u32x4 hv = *(const u32x4*)(hr + 8 * lane + 512 * j);
                v[j][0] = (f32x4){bflo(hv[0]), bfhi(hv[0]), bflo(hv[1]), bfhi(hv[1])}; v[j][1] = (f32x4){bflo(hv[2]), bfhi(hv[2]), bflo(hv[3]), bfhi(hv[3])};
                const int qidx = tabq[(m >> 8) * 8 + 2 * j + (lane >> 5)];
                if (qidx >= 0) {
                    const float* p0 = scr6 + ((size_t)qidx * 256 + (m & 255)) * 256 + 8 * (lane & 31); const float* p1 = p0 + (size_t)32 * 65536;
                    v[j][0] += *(const f32x4*)p0 + *(const f32x4*)p1; v[j][1] += *(const f32x4*)(p0 + 4) + *(const f32x4*)(p1 + 4);
                }
#pragma unroll
                for (int e = 0; e < 4; ++e) s2 += v[j][0][e] * v[j][0][e] + v[j][1][e] * v[j][1][e];
            }
            const float rstd = __builtin_amdgcn_rsqf(wave_sum(s2) * (1.0f / DM) + EPS);
#pragma unroll
            for (int j = 0; j < 4; ++j) { const float* gp = a.in[I_FG] + 8 * lane + 512 * j; const f32x4 g0 = *(const f32x4*)gp, g1 = *(const f32x4*)(gp + 4);
                *(f32x4*)(yr + 8 * lane + 512 * j) = v[j][0] * rstd * g0; *(f32x4*)(yr + 8 * lane + 512 * j + 4) = v[j][1] * rstd * g1; }
        }
    }
#undef IN
#undef SEAM
}

extern "C" void kernel_launch(void* const* d_in, const int* in_sizes, int n_in, void* d_out, int out_size, void* d_ws, size_t ws_size, hipStream_t stream) {
    static int grid = 0;
    if (grid == 0) {
        if (n_in != 23 || (size_t)out_size != O_END || ws_size < WS_END) { fprintf(stderr, "kernel_launch: unexpected shapes: n_in %d out %d ws %zu\n", n_in, out_size, ws_size); grid = -1; return; }
        int dev = 0, cus = 0, per_cu = 0;
        hipGetDevice(&dev); hipDeviceGetAttribute(&cus, hipDeviceAttributeMultiprocessorCount, dev);
        if (hipFuncSetAttribute((const void*)mk_fwd, hipFuncAttributeMaxDynamicSharedMemorySize, LDS_BYTES) != hipSuccess) { fprintf(stderr, "kernel_launch: hipFuncSetAttribute failed\n"); grid = -1; return; }
        if (hipOccupancyMaxActiveBlocksPerMultiprocessor(&per_cu, (const void*)mk_fwd, 512, LDS_BYTES) != hipSuccess || per_cu < 1) { fprintf(stderr, "kernel_launch: occupancy query says %d\n", per_cu); per_cu = 1; }
        (void)hipGetLastError();
        grid = cus * 1;
    }
    if (grid < 0) return;
    (void)hipMemsetAsync((char*)d_ws + WS_CTL, 0, CTL_BYTES, stream);
    Args a{};
    for (int i = 0; i < 23; ++i) a.in[i] = (const float*)d_in[i];
    a.out = (float*)d_out; a.ws = (unsigned char*)d_ws;
#if MK_MULTI
    for (int p = 0; p < NPH; ++p) { a.ph_lo = p; a.ph_hi = p + 1; hipLaunchKernelGGL(mk_fwd, dim3(grid), dim3(512), LDS_BYTES, stream, a); }
#else
    a.ph_lo = 0; a.ph_hi = NPH;
    void* args[] = {&a};
    hipError_t e = hipLaunchCooperativeKernel((const void*)mk_fwd, dim3(grid), dim3(512), args, LDS_BYTES, stream);
    if (e != hipSuccess) fprintf(stderr, "kernel_launch: cooperative launch failed: %s\n", hipGetErrorString(e));
#endif
}
```

```cpp
#include <hip/hip_runtime.h>
#include <hip/hip_cooperative_groups.h>
#include <cstdio>
#include <cstdint>
namespace cg = cooperative_groups;

#ifndef PROBE_DUP
#define PROBE_DUP 0
#endif
#ifndef MK_MULTI
#define MK_MULTI 0
#endif

#define LAS __attribute__((address_space(3)))
typedef unsigned short bf16_t;
typedef short bf16x8 __attribute__((ext_vector_type(8)));
typedef float f32x4 __attribute__((ext_vector_type(4)));
typedef float f32x16 __attribute__((ext_vector_type(16)));
typedef unsigned u32x4 __attribute__((ext_vector_type(4)));
typedef unsigned u32x2 __attribute__((ext_vector_type(2)));
typedef float f32x2_t __attribute__((ext_vector_type(2)));
typedef __bf16 bf16x2_t __attribute__((ext_vector_type(2)));

constexpr int DM = 2048, NBATCH = 4, SEQ = 4096, DBATCH = 16, DSEQ = 64, PAST = 1024;
constexpr int MP = NBATCH * SEQ, MS = DBATCH * DSEQ, MTOT = MP + MS;
constexpr int NH = 8, DV = 128, DFF = 5632, NIN = 10240, PLD = 9216;
constexpr float EPS = 1e-6f;
constexpr float LOG2E = 1.4426950408889634f;
constexpr int PC_Q = 0, PC_K = 1024, PC_B = 2048, PC_C = 3072, PC_X = 4096, PC_GA = 5120, PC_GB = 7168;
constexpr size_t O_Y = 0;
constexpr size_t O_KP = (size_t)MTOT * DM;
constexpr size_t O_VP = O_KP + (size_t)MP * 1024;
constexpr size_t O_CMP = O_VP + (size_t)MP * 1024;
constexpr size_t O_CFP = O_CMP + (size_t)NBATCH * 2 * 1024;
constexpr size_t O_KS = O_CFP + (size_t)NBATCH * 2 * 2 * DFF;
constexpr size_t O_VS = O_KS + (size_t)MS * 1024;
constexpr size_t O_CMS = O_VS + (size_t)MS * 1024;
constexpr size_t O_CFS = O_CMS + (size_t)DBATCH * 2 * 1024;
constexpr size_t O_END = O_CFS + (size_t)DBATCH * 2 * 2 * DFF;
constexpr size_t MiB = 1u << 20;
constexpr size_t WS_CTL = 0, CTL_BYTES = 1 * MiB;
constexpr size_t WS_ROWSS = 64 * 1024;
constexpr size_t WS_RSTD1 = 512 * 1024;
constexpr size_t WS_WIN = 1 * MiB;
constexpr size_t WS_WAB = 41 * MiB;
constexpr size_t WS_WO = 49 * MiB;
constexpr size_t WS_PROJ = 57 * MiB;
constexpr size_t WS_KC = 363 * MiB;
constexpr size_t WS_VTC = 395 * MiB;
constexpr size_t WS_VTP = 427 * MiB;
constexpr size_t WS_VTN = 459 * MiB;
constexpr size_t WS_MERGED = 363 * MiB;
constexpr size_t WS_WUP = 431 * MiB;
constexpr size_t WS_WDN = 475 * MiB;
constexpr size_t WS_HB = 57 * MiB;
constexpr size_t WS_ACT = 125 * MiB;
constexpr size_t WS_TH = 312 * MiB;
constexpr size_t WS_SCR6 = 363 * MiB;
constexpr size_t WS_END = 497 * MiB;

constexpr int LDS_BYTES = 156160;
constexpr int XB_OFF = 131072;
constexpr int TAB_OFF = 147456;
constexpr int MISC_OFF = 155648;

__device__ __forceinline__ unsigned cvtpk(float lo, float hi) { f32x2_t v = {lo, hi}; bf16x2_t b = __builtin_convertvector(v, bf16x2_t); return __builtin_bit_cast(unsigned, b); }
__device__ __forceinline__ float bf2f(unsigned short b) { return __builtin_bit_cast(float, (unsigned)b << 16); }
__device__ __forceinline__ float bflo(unsigned w) { return __builtin_bit_cast(float, w << 16); }
__device__ __forceinline__ float bfhi(unsigned w) { return __builtin_bit_cast(float, w & 0xffff0000u); }
__device__ __forceinline__ float sigmoidf_(float x) { return __builtin_amdgcn_rcpf(1.0f + __builtin_amdgcn_exp2f(-x * LOG2E)); }
__device__ __forceinline__ void swap32(float& a, float& b) { asm volatile("s_nop 1\n\tv_permlane32_swap_b32 %0, %1\n\ts_nop 1" : "+v"(a), "+v"(b)); }
template <int CTRL> __device__ __forceinline__ float dppf(float v) { return __builtin_bit_cast(float, __builtin_amdgcn_update_dpp(0, __builtin_bit_cast(int, v), CTRL, 0xf, 0xf, true)); }

namespace pg8 {
constexpr int BM = 256, BK = 64, HALF = 128, HTB = HALF * BK * 2, STAGE_BYTES = 8 * HTB, NXCD = 8, WGM = 8;
__host__ __device__ __forceinline__ int lds_byte(int r, int c) { const int st = (r >> 4) * 2 + (c >> 5), rr = r & 15, cc = c & 31, ob = rr * 64 + cc * 2; return st * 1024 + (ob ^ (((ob >> 9) & 1) << 5)); }
__host__ __device__ __forceinline__ void stage_rc(int b, int& R, int& C) { const int st = b / 1024, sb = b % 1024, swz = sb ^ (((sb >> 9) & 1) << 5); R = (st >> 1) * 16 + swz / 64; C = (st & 1) * 32 + (swz % 64) / 2; }
__host__ __device__ __forceinline__ int perm32(int rho) { const int n = rho >> 4, i = rho & 15; return 8 * (i >> 2) + 4 * n + (i & 3); }

struct Unit { int pm, pn, ra, cb; };
struct Gemm { const bf16_t* A; const bf16_t* Bt; int lda, ldb, K; };
struct StaticOrder {
    int nM, nN, nwg, G, c, lim;
    __device__ void init(int nM_, int nN_, int G_, int c_, int lim_ = 0x7fffffff) { nM = nM_; nN = nN_; nwg = nM * nN; G = G_; c = c_; lim = lim_ < nwg ? lim_ : nwg; }
    __device__ void unit_of(int L, Unit& u) const {
        int wgid = L; { const int q = nwg / NXCD, r = nwg % NXCD, xcd = wgid % NXCD, off = wgid / NXCD; wgid = (xcd < r ? xcd * (q + 1) : r * (q + 1) + (xcd - r) * q) + off; }
        const int nig = WGM * nN, gid = wgid / nig, fm = gid * WGM, gsz = (nM - fm) < WGM ? (nM - fm) : WGM;
        u.pm = fm + ((wgid % nig) % gsz); u.pn = (wgid % nig) / gsz; u.ra = 0; u.cb = 0;
    }
    __device__ bool next(int i, Unit& u) const {
        const long L = (long)i * G + c; if (L >= lim) return false;
        unit_of((int)L, u); return true;
    }
};

template <class Epi>
__device__ __forceinline__ void gemm_phase(LAS unsigned char* lds, const Gemm g, const StaticOrder& S, const Epi& E) {
    const int tid = threadIdx.x, wid = __builtin_amdgcn_readfirstlane(tid >> 6), lane = tid & 63, wr = wid >> 2, wc = wid & 3, fr = lane & 15, fq = lane >> 4;
    const int K = g.K, nt = K / BK;
    unsigned voffA[2], voffB[2];
#pragma unroll
    for (int i = 0; i < 2; ++i) { int R, C; stage_rc(tid * 16 + i * 8192, R, C); const int Rb = (R & ~31) + perm32(R & 31);
        voffA[i] = (unsigned)(R * g.lda + C) * 2u; voffB[i] = (unsigned)(Rb * g.ldb + C) * 2u; }
    const size_t kstep = (size_t)(BK * 2);
    const size_t hstepA = (size_t)HALF * g.lda * 2, hstepB = (size_t)HALF * g.ldb * 2;
    const size_t tstepA = 2 * hstepA, tstepB = 2 * hstepB;
    const unsigned ldsw = (unsigned)wid * 1024u;
    const int aoff = lds_byte(wr * 64 + fr, fq * 8), boff = lds_byte(wc * 32 + fr, fq * 8);
#define PG8_SA(b, h) (((b) * 2 + (h)) * HTB)
#define PG8_SB(b, h) ((4 + (b) * 2 + (h)) * HTB)
#define PG8_STAGE(bufoff, gbase, voff) do { _Pragma("unroll") for (int _i = 0; _i < 2; ++_i) \
        __builtin_amdgcn_global_load_lds((const unsigned*)((const char*)(gbase) + (voff)[_i]), (LAS unsigned*)(lds + (bufoff) + ldsw + _i * 8192), 16, 0, 0); } while (0)
#define PG8_LDA(dst, b, h) do { _Pragma("unroll") for (int m = 0; m < 4; ++m) _Pragma("unroll") for (int k = 0; k < 2; ++k) dst[m][k] = *(const LAS bf16x8*)(lds + PG8_SA(b, h) + aoff + m * 2048 + k * 1024); } while (0)
#define PG8_LDB(dst, b, h) do { _Pragma("unroll") for (int n = 0; n < 2; ++n) _Pragma("unroll") for (int k = 0; k < 2; ++k) dst[n][k] = *(const LAS bf16x8*)(lds + PG8_SB(b, h) + boff + n * 2048 + k * 1024); } while (0)
#define PG8_MMA(ai, bj, At, Bt) do { __builtin_amdgcn_s_setprio(1); _Pragma("unroll") for (int m = 0; m < 4; ++m) _Pragma("unroll") for (int n = 0; n < 2; ++n) _Pragma("unroll") for (int k = 0; k < 2; ++k) \
        acc[ai][bj][m][n] = __builtin_amdgcn_mfma_f32_16x16x32_bf16(Bt[n][k], At[m][k], acc[ai][bj][m][n], 0, 0, 0); __builtin_amdgcn_s_setprio(0); } while (0)
#define PG8_WAIT_V(n) asm volatile("s_waitcnt vmcnt(" #n ")" ::: "memory")
#define PG8_WAIT_L(n) asm volatile("s_waitcnt lgkmcnt(" #n ")" ::: "memory")
#define PG8_BAR __builtin_amdgcn_s_barrier()
#define PG8_SCHED __builtin_amdgcn_sched_barrier(0)
    Unit cur, nxt; int ui = 0;
    if (!S.next(0, cur)) return;
    f32x4 acc[2][2][4][2];
#pragma unroll
    for (int a = 0; a < 2; ++a)
#pragma unroll
        for (int b = 0; b < 2; ++b)
#pragma unroll
            for (int m = 0; m < 4; ++m)
#pragma unroll
                for (int n = 0; n < 2; ++n) acc[a][b][m][n] = (f32x4){0.f, 0.f, 0.f, 0.f};
    bf16x8 At[4][2], B0[2][2], B1[2][2];
    const char* cA = (const char*)g.A + (size_t)cur.pm * tstepA; const char* cB = (const char*)g.Bt + (size_t)cur.pn * tstepB;
    PG8_STAGE(PG8_SB(0, 0), cB, voffB); PG8_STAGE(PG8_SB(0, 1), cB + hstepB, voffB); PG8_STAGE(PG8_SA(0, 0), cA, voffA); PG8_STAGE(PG8_SA(0, 1), cA + hstepA, voffA);
    if (wr == 1) PG8_BAR;
    PG8_WAIT_V(2); PG8_BAR;
    PG8_STAGE(PG8_SB(1, 0), cB + kstep, voffB); PG8_STAGE(PG8_SA(1, 0), cA + kstep, voffA); PG8_STAGE(PG8_SB(1, 1), cB + hstepB + kstep, voffB);
    PG8_WAIT_V(6); PG8_BAR;
#define PG8_KLOOP(cA_, cB_, nA_, nB_) \
        for (int t = 0; t < nt; t += 2) { \
            const bool last = (t == nt - 2); \
            const char* a1 = (cA_) + (size_t)(t + 1) * kstep; \
            const char* a2 = last ? (nA_) : (cA_) + (size_t)(t + 2) * kstep; const char* b2 = last ? (nB_) : (cB_) + (size_t)(t + 2) * kstep; \
            const char* a3 = a2 + kstep; const char* b3 = b2 + kstep; \
            PG8_LDB(B0, 0, 0); PG8_LDB(B1, 0, 1); PG8_SCHED; PG8_LDA(At, 0, 0); PG8_STAGE(PG8_SA(1, 1), a1 + hstepA, voffA); \
            PG8_WAIT_V(8); PG8_WAIT_L(0); PG8_BAR; PG8_MMA(0, 0, At, B0); PG8_MMA(0, 1, At, B1); PG8_BAR; PG8_SCHED; \
            PG8_LDA(At, 0, 1); PG8_STAGE(PG8_SB(0, 0), b2, voffB); PG8_STAGE(PG8_SB(0, 1), b2 + hstepB, voffB); PG8_STAGE(PG8_SA(0, 0), a2, voffA); \
            PG8_WAIT_V(8); PG8_WAIT_L(0); PG8_BAR; PG8_MMA(1, 0, At, B0); PG8_MMA(1, 1, At, B1); PG8_BAR; PG8_SCHED; \
            PG8_LDB(B0, 1, 0); PG8_LDB(B1, 1, 1); PG8_SCHED; PG8_LDA(At, 1, 0); PG8_STAGE(PG8_SA(0, 1), a2 + hstepA, voffA); \
            PG8_WAIT_V(8); PG8_WAIT_L(0); PG8_BAR; PG8_MMA(0, 0, At, B0); PG8_MMA(0, 1, At, B1); PG8_BAR; PG8_SCHED; \
            PG8_LDA(At, 1, 1); PG8_STAGE(PG8_SB(1, 0), b3, voffB); PG8_STAGE(PG8_SB(1, 1), b3 + hstepB, voffB); PG8_STAGE(PG8_SA(1, 0), a3, voffA); \
            PG8_WAIT_V(8); PG8_WAIT_L(0); PG8_BAR; PG8_MMA(1, 0, At, B0); PG8_MMA(1, 1, At, B1); PG8_BAR; PG8_SCHED; \
        }
    for (;;) {
        if constexpr (Epi::NPART == 2) {
            const char* mA = cA + (size_t)K * 2; const char* mB = cB + (size_t)K * 2;
            PG8_KLOOP(cA, cB, mA, mB)
            E.mid(acc, cur, wr, wc, fr, fq);
            cA = mA; cB = mB;
        }
        const bool has_next = S.next(ui + 1, nxt);
        const char* nA = has_next ? (const char*)g.A + (size_t)nxt.pm * tstepA : cA; const char* nB = has_next ? (const char*)g.Bt + (size_t)nxt.pn * tstepB : cB;
        PG8_KLOOP(cA, cB, nA, nB)
        if (wr == 0) PG8_BAR;
        E(acc, cur, wr, wc, fr, fq);
        if (!has_next) break;
#pragma unroll
        for (int a = 0; a < 2; ++a)
#pragma unroll
            for (int b = 0; b < 2; ++b)
#pragma unroll
                for (int m = 0; m < 4; ++m)
#pragma unroll
                    for (int n = 0; n < 2; ++n) acc[a][b][m][n] = (f32x4){0.f, 0.f, 0.f, 0.f};
        cur = nxt; cA = nA; cB = nB; ++ui;
        if (wr == 1) PG8_BAR;
    }
#undef PG8_KLOOP
    PG8_WAIT_V(0);
    PG8_BAR;
#undef PG8_SA
#undef PG8_SB
#undef PG8_STAGE
#undef PG8_LDA
#undef PG8_LDB
#undef PG8_MMA
#undef PG8_WAIT_V
#undef PG8_WAIT_L
#undef PG8_BAR
#undef PG8_SCHED
}

template <class Epi>
__device__ __forceinline__ void gemm_quarter(LAS unsigned char* lds, const Gemm g, const Unit u, const Epi& E) {
    const int tid = threadIdx.x, wid = __builtin_amdgcn_readfirstlane(tid >> 6), lane = tid & 63, wr = wid >> 2, wc = wid & 3, fr = lane & 15, fq = lane >> 4;
    const int K = g.K, nt = K / BK;
    unsigned voffA[2], voffB[2];
#pragma unroll
    for (int i = 0; i < 2; ++i) { int R, C; stage_rc(tid * 16 + i * 8192, R, C); const int Rb = (R & ~31) + perm32(R & 31);
        voffA[i] = (unsigned)(R * g.lda + C) * 2u; voffB[i] = (unsigned)(Rb * g.ldb + C) * 2u; }
    const unsigned ldsw = (unsigned)wid * 1024u;
    const int aoff = lds_byte(wr * 64 + fr, fq * 8), boff = lds_byte(wc * 32 + fr, fq * 8);
    const char* cA = (const char*)g.A + ((size_t)u.pm * 256 + u.ra) * g.lda * 2; const char* cB = (const char*)g.Bt + ((size_t)u.pn * 256 + u.cb) * g.ldb * 2;
    f32x4 acc[2][2][4][2];
#pragma unroll
    for (int m = 0; m < 4; ++m)
#pragma unroll
        for (int n = 0; n < 2; ++n) acc[0][0][m][n] = (f32x4){0.f, 0.f, 0.f, 0.f};
#define QSTAGE(r, kt) do { _Pragma("unroll") for (int _i = 0; _i < 2; ++_i) { \
        __builtin_amdgcn_global_load_lds((const unsigned*)(cA + (size_t)(kt) * (BK * 2) + voffA[_i]), (LAS unsigned*)(lds + (r) * HTB + ldsw + _i * 8192), 16, 0, 0); \
        __builtin_amdgcn_global_load_lds((const unsigned*)(cB + (size_t)(kt) * (BK * 2) + voffB[_i]), (LAS unsigned*)(lds + (4 + (r)) * HTB + ldsw + _i * 8192), 16, 0, 0); } } while (0)
    for (int part = 0; part < Epi::NPART; ++part) {
        QSTAGE(0, 0); QSTAGE(1, 1); QSTAGE(2, 2);
        for (int t = 0; t < nt; ++t) {
            if (t + 3 < nt) { QSTAGE((t + 3) & 3, t + 3); asm volatile("s_waitcnt vmcnt(12)" ::: "memory"); }
            else if (t + 2 < nt) asm volatile("s_waitcnt vmcnt(8)" ::: "memory");
            else if (t + 1 < nt) asm volatile("s_waitcnt vmcnt(4)" ::: "memory");
            else asm volatile("s_waitcnt vmcnt(0)" ::: "memory");
            __builtin_amdgcn_s_barrier();
            const int r = t & 3;
            bf16x8 At[4][2], B0[2][2];
#pragma unroll
            for (int m = 0; m < 4; ++m)
#pragma unroll
                for (int k = 0; k < 2; ++k) At[m][k] = *(const LAS bf16x8*)(lds + r * HTB + aoff + m * 2048 + k * 1024);
#pragma unroll
            for (int n = 0; n < 2; ++n)
#pragma unroll
                for (int k = 0; k < 2; ++k) B0[n][k] = *(const LAS bf16x8*)(lds + (4 + r) * HTB + boff + n * 2048 + k * 1024);
            asm volatile("s_waitcnt lgkmcnt(0)" ::: "memory");
#pragma unroll
            for (int m = 0; m < 4; ++m)
#pragma unroll
                for (int n = 0; n < 2; ++n)
#pragma unroll
                    for (int k = 0; k < 2; ++k) acc[0][0][m][n] = __builtin_amdgcn_mfma_f32_16x16x32_bf16(B0[n][k], At[m][k], acc[0][0][m][n], 0, 0, 0);
            __builtin_amdgcn_s_barrier();
        }
        if constexpr (Epi::NPART > 1) { if (part + 1 < Epi::NPART) { E.template mid<1, 1>(acc, u, wr, wc, fr, fq); cA += (size_t)K * 2; cB += (size_t)K * 2; } }
    }
#undef QSTAGE
    E.template operator()<1, 1>(acc, u, wr, wc, fr, fq);
}
}
using pg8::Unit;

#define EPI_ARGS f32x4 (&acc)[2][2][4][2], const Unit& u, int wr, int wc, int fr, int fq
__device__ __forceinline__ void store_bf8(bf16_t* p, f32x4 v0, f32x4 v1) {
    u32x4 w; w.x = cvtpk(v0[0], v0[1]); w.y = cvtpk(v0[2], v0[3]); w.z = cvtpk(v1[0], v1[1]); w.w = cvtpk(v1[2], v1[3]); *(u32x4*)p = w;
}

struct Epi1 {
    static constexpr int NPART = 1;
    bf16_t* proj; float* out; bf16_t* vtp; bf16_t* vtn; const float* rstd1;
    __device__ __forceinline__ void operator()(EPI_ARGS) const {
        const int pn = u.pn; const bool samp = u.pm >= 64;
        const int colt = pn * 256 + wc * 32 + 8 * fq;
#pragma unroll
        for (int ai = 0; ai < 2; ++ai)
#pragma unroll
            for (int m = 0; m < 4; ++m) {
                const int row = u.pm * 256 + ai * 128 + wr * 64 + m * 16 + fr;
                { const float rs = rstd1[row];
#pragma unroll
                  for (int bj = 0; bj < 2; ++bj) { acc[ai][bj][m][0] *= rs; acc[ai][bj][m][1] *= rs; } }
                if (pn >= 24) {
                    const int ch0 = (pn - 24) * 128 + wc * 32 + 8 * fq; f32x4 r0, r1, s0, s1;
#pragma unroll
                    for (int e = 0; e < 4; ++e) {
                        const float ea0 = __builtin_amdgcn_exp2f(-acc[ai][0][m][0][e] * LOG2E), eb0 = __builtin_amdgcn_exp2f(-acc[ai][1][m][0][e] * LOG2E);
                        const float ea1 = __builtin_amdgcn_exp2f(-acc[ai][0][m][1][e] * LOG2E), eb1 = __builtin_amdgcn_exp2f(-acc[ai][1][m][1][e] * LOG2E);
                        r0[e] = (1.f + eb0) * __builtin_amdgcn_rcpf(1.f + ea0); r1[e] = (1.f + eb1) * __builtin_amdgcn_rcpf(1.f + ea1);
                        s0[e] = __builtin_amdgcn_rcpf(1.f + eb0); s1[e] = __builtin_amdgcn_rcpf(1.f + eb1);
                    }
                    store_bf8(proj + (size_t)row * PLD + PC_GA + ch0, r0, r1); store_bf8(proj + (size_t)row * PLD + PC_GB + ch0, s0, s1);
                    continue;
                }
                if (pn >= 16) {
                    const int ch0 = (pn - 16) * 128 + wc * 32 + 8 * fq;
                    store_bf8(proj + (size_t)row * PLD + PC_C + ch0, acc[ai][0][m][0] * acc[ai][1][m][0], acc[ai][0][m][1] * acc[ai][1][m][1]);
                    continue;
                }
#pragma unroll
                for (int bj = 0; bj < 2; ++bj) {
                    const int col = colt + bj * 128; const f32x4 v0 = acc[ai][bj][m][0], v1 = acc[ai][bj][m][1];
                    if (pn < 8 || pn >= 12) { const int pcol = col < 2048 ? col : col - 1024; store_bf8(proj + (size_t)row * PLD + pcol, v0, v1); }
                    if (pn >= 8 && pn < 12) {
                        const int cv = col - 2048;
                        bf16_t* vt; size_t pitch;
                        if (samp) { const int r2 = row - MP; vt = vtn + ((size_t)(r2 >> 6) * 1024 + cv) * 64 + (r2 & 63); pitch = 64; }
                        else { vt = vtp + ((size_t)(row >> 12) * 1024 + cv) * 4096 + (row & 4095); pitch = 4096; }
#pragma unroll
                        for (int e = 0; e < 4; ++e) { vt[(size_t)e * pitch] = (bf16_t)(cvtpk(v0[e], 0.f) & 0xffffu); vt[(size_t)(e + 4) * pitch] = (bf16_t)(cvtpk(v1[e], 0.f) & 0xffffu); }
                    }
                }
            }
    }
};

struct Epi3 {
    static constexpr int NPART = 2;
    const bf16_t* proj; bf16_t* merged;
    template <int NAI = 2, int NBJ = 2>
    __device__ __forceinline__ void mid(EPI_ARGS) const {
        unsigned lo_ = (unsigned)((wr * 64 + fr) * PLD + wc * 32 + 8 * fq) * 2u; asm volatile("" : "+v"(lo_));
        const char* pb = (const char*)proj + (((size_t)u.pm * 256 + u.ra) * PLD + u.pn * 256 + u.cb) * 2;
#pragma unroll
        for (int ai = 0; ai < NAI; ++ai)
#pragma unroll
            for (int m = 0; m < 4; ++m) {
#pragma unroll
                for (int bj = 0; bj < NBJ; ++bj) {
                    const unsigned off = lo_ + (unsigned)(((ai * 128 + m * 16) * PLD + bj * 128) * 2);
                    const u32x4 rv = *(const u32x4*)(pb + off + PC_GA * 2);
                    acc[ai][bj][m][0][0] *= bflo(rv[0]); acc[ai][bj][m][0][1] *= bfhi(rv[0]); acc[ai][bj][m][0][2] *= bflo(rv[1]); acc[ai][bj][m][0][3] *= bfhi(rv[1]);
                    acc[ai][bj][m][1][0] *= bflo(rv[2]); acc[ai][bj][m][1][1] *= bfhi(rv[2]); acc[ai][bj][m][1][2] *= bflo(rv[3]); acc[ai][bj][m][1][3] *= bfhi(rv[3]);
                    asm volatile("" : "+v"(acc[ai][bj][m][0]), "+v"(acc[ai][bj][m][1]) :: "memory");
                }
            }
    }
    template <int NAI = 2, int NBJ = 2>
    __device__ __forceinline__ void operator()(EPI_ARGS) const {
        unsigned lo_ = (unsigned)((wr * 64 + fr) * PLD + wc * 32 + 8 * fq) * 2u; asm volatile("" : "+v"(lo_));
        unsigned mo_ = (unsigned)((wr * 64 + fr) * DM + wc * 32 + 8 * fq) * 2u; asm volatile("" : "+v"(mo_));
        const char* pb = (const char*)proj + (((size_t)u.pm * 256 + u.ra) * PLD + u.pn * 256 + u.cb) * 2;
        char* mb = (char*)merged + (((size_t)u.pm * 256 + u.ra) * DM + u.pn * 256 + u.cb) * 2;
#pragma unroll
        for (int ai = 0; ai < NAI; ++ai)
#pragma unroll
            for (int m = 0; m < 4; ++m) {
#pragma unroll
                for (int bj = 0; bj < NBJ; ++bj) {
                    const unsigned off = lo_ + (unsigned)(((ai * 128 + m * 16) * PLD + bj * 128) * 2);
                    const u32x4 gb = *(const u32x4*)(pb + off + PC_GB * 2);
                    f32x4 v0 = acc[ai][bj][m][0], v1 = acc[ai][bj][m][1];
                    v0[0] *= bflo(gb[0]); v0[1] *= bfhi(gb[0]); v0[2] *= bflo(gb[1]); v0[3] *= bfhi(gb[1]);
                    v1[0] *= bflo(gb[2]); v1[1] *= bfhi(gb[2]); v1[2] *= bflo(gb[3]); v1[3] *= bfhi(gb[3]);
                    store_bf8((bf16_t*)(mb + mo_ + (unsigned)(((ai * 128 + m * 16) * DM + bj * 128) * 2)), v0, v1);
                }
                asm volatile("" ::: "memory");
            }
    }
};

struct Epi4 {
    static constexpr int NPART = 1;
    const bf16_t* xb; bf16_t* hb; float* rowss;
    template <int NAI = 2, int NBJ = 2>
    __device__ __forceinline__ void operator()(EPI_ARGS) const {
        const int col0 = u.pn * 256 + u.cb + wc * 32 + 8 * fq;
#pragma unroll
        for (int ai = 0; ai < NAI; ++ai)
#pragma unroll
            for (int m = 0; m < 4; ++m) {
                const int row = u.pm * 256 + u.ra + ai * 128 + wr * 64 + m * 16 + fr;
                float ss = 0.f;
#pragma unroll
                for (int bj = 0; bj < NBJ; ++bj) {
                    const int col = col0 + bj * 128;
                    const u32x4 xv = *(const u32x4*)(xb + (size_t)row * DM + col);
                    f32x4 h0 = acc[ai][bj][m][0], h1 = acc[ai][bj][m][1];
                    h0[0] += bflo(xv[0]); h0[1] += bfhi(xv[0]); h0[2] += bflo(xv[1]); h0[3] += bfhi(xv[1]);
                    h1[0] += bflo(xv[2]); h1[1] += bfhi(xv[2]); h1[2] += bflo(xv[3]); h1[3] += bfhi(xv[3]);
                    store_bf8(hb + (size_t)row * DM + col, h0, h1);
                    ss += (h0[0] * h0[0] + h0[1] * h0[1]) + (h0[2] * h0[2] + h0[3] * h0[3]) + (h1[0] * h1[0] + h1[1] * h1[1]) + (h1[2] * h1[2] + h1[3] * h1[3]);
                }
                ss += __shfl_xor(ss, 16); ss += __shfl_xor(ss, 32);
                if (fq == 0) atomicAdd(rowss + row, ss);
            }
    }
};

struct Epi5 {
    static constexpr int NPART = 1;
    const float* rowss; const float* cw; const float* st_in; bf16_t* act; float* th; float* out; LAS unsigned char* xb;
    __device__ __forceinline__ void operator()(EPI_ARGS) const {
        const int pm = u.pm, pn = u.pn; const bool samp = pm >= 64;
        const int cl = wc * 32 + 8 * fq, ch0 = pn * 128 + cl;
#pragma unroll
        for (int ai = 0; ai < 2; ++ai) {
            const int blk = 2 * ai + wr, R0 = pm * 256 + ai * 128 + wr * 64;
#pragma unroll
            for (int m = 0; m < 4; ++m) {
                const float rs = __builtin_amdgcn_rsqf(rowss[R0 + 16 * m + fr] * (1.0f / DM) + EPS);
#pragma unroll
                for (int bj = 0; bj < 2; ++bj)
#pragma unroll
                    for (int n = 0; n < 2; ++n) acc[ai][bj][m][n] *= rs;
            }
            if (fr >= 14) {
                const int tr = fr - 14;
#pragma unroll
                for (int bj = 0; bj < 2; ++bj)
#pragma unroll
                    for (int n = 0; n < 2; ++n) {
                        const f32x4 v = acc[ai][bj][3][n]; const int gc = bj * DFF + ch0 + 4 * n;
                        *(LAS f32x4*)(xb + ((blk * 2 + tr) * 256 + bj * 128 + cl + 4 * n) * 4) = v;
                        if (samp) { const int b = (pm - 64) * 4 + blk; *(f32x4*)(out + O_CFS + (size_t)(b * 2 + tr) * (2 * DFF) + gc) = v; }
                        else if (blk == 3) {
                            *(f32x4*)(th + (size_t)(pm * 4 + 2 + tr) * (2 * DFF) + gc) = v;
                            if ((pm & 15) == 15) *(f32x4*)(out + O_CFP + (size_t)((pm >> 4) * 2 + tr) * (2 * DFF) + gc) = v;
                        }
                    }
            }
            if (!samp && blk == 0 && fr < 2) {
#pragma unroll
                for (int bj = 0; bj < 2; ++bj)
#pragma unroll
                    for (int n = 0; n < 2; ++n) *(f32x4*)(th + (size_t)(pm * 4 + fr) * (2 * DFF) + bj * DFF + ch0 + 4 * n) = acc[ai][bj][0][n];
            }
        }
        asm volatile("s_waitcnt lgkmcnt(0)" ::: "memory"); __builtin_amdgcn_s_barrier(); asm volatile("" ::: "memory");
#pragma unroll
        for (int ai = 0; ai < 2; ++ai) {
            const int blk = 2 * ai + wr, R0 = pm * 256 + ai * 128 + wr * 64;
#pragma unroll
            for (int n = 0; n < 2; ++n) {
                f32x4 w[3][2], P[2];
#pragma unroll
                for (int j = 0; j < 3; ++j)
#pragma unroll
                    for (int bj = 0; bj < 2; ++bj) w[j][bj] = *(const f32x4*)(cw + (size_t)j * (2 * DFF) + bj * DFF + ch0 + 4 * n);
#pragma unroll
                for (int bj = 0; bj < 2; ++bj) P[bj] = (f32x4){0.f, 0.f, 0.f, 0.f};
                if (fr >= 14) {
                    const int tr = fr - 14;
                    if (samp) {
                        const int b = (pm - 64) * 4 + blk;
#pragma unroll
                        for (int bj = 0; bj < 2; ++bj) P[bj] = *(const f32x4*)(st_in + (size_t)(b * 2 + tr) * (2 * DFF) + bj * DFF + ch0 + 4 * n);
                    } else if (blk > 0) {
#pragma unroll
                        for (int bj = 0; bj < 2; ++bj) P[bj] = *(const LAS f32x4*)(xb + (((blk - 1) * 2 + tr) * 256 + bj * 128 + cl + 4 * n) * 4);
                    }
                }
#pragma unroll
                for (int m = 0; m < 4; ++m) {
                    const int row = R0 + 16 * m + fr;
                    f32x4 yv[2];
#pragma unroll
                    for (int bj = 0; bj < 2; ++bj)
#pragma unroll
                        for (int e = 0; e < 4; ++e) {
                            const float x = acc[ai][bj][m][n][e];
                            const float pr = (m == 0) ? P[bj][e] : acc[ai][bj][(m + 3) & 3][n][e];
                            const float x1 = dppf<0x111>(x) + dppf<0x10F>(pr);
                            const float x2 = dppf<0x112>(x) + dppf<0x10E>(pr);
                            float y_ = __builtin_fmaf(w[0][bj][e], x2, __builtin_fmaf(w[1][bj][e], x1, w[2][bj][e] * x)); asm("" : "+v"(y_));
                            yv[bj][e] = y_;
                        }
                    u32x2 o;
                    o.x = cvtpk(yv[0][0] * sigmoidf_(yv[0][0]) * yv[1][0], yv[0][1] * sigmoidf_(yv[0][1]) * yv[1][1]);
                    o.y = cvtpk(yv[0][2] * sigmoidf_(yv[0][2]) * yv[1][2], yv[0][3] * sigmoidf_(yv[0][3]) * yv[1][3]);
                    *(u32x2*)(act + (size_t)row * DFF + ch0 + 4 * n) = o;
                }
                asm volatile("" ::: "memory");
            }
        }
    }
};

struct Epi6 {
    static constexpr int NPART = 1;
    bf16_t* hb;
    template <int NAI = 2, int NBJ = 2>
    __device__ __forceinline__ void operator()(EPI_ARGS) const {
        const int col0 = u.pn * 256 + u.cb + wc * 32 + 8 * fq;
#pragma unroll
        for (int ai = 0; ai < NAI; ++ai)
#pragma unroll
            for (int m = 0; m < 4; ++m) {
                const int row = u.pm * 256 + u.ra + ai * 128 + wr * 64 + m * 16 + fr;
#pragma unroll
                for (int bj = 0; bj < NBJ; ++bj) {
                    bf16_t* p = hb + (size_t)row * DM + col0 + bj * 128;
                    const u32x4 hv = *(const u32x4*)p;
                    f32x4 h0 = acc[ai][bj][m][0], h1 = acc[ai][bj][m][1];
                    h0[0] += bflo(hv[0]); h0[1] += bfhi(hv[0]); h0[2] += bflo(hv[1]); h0[3] += bfhi(hv[1]);
                    h1[0] += bflo(hv[2]); h1[1] += bfhi(hv[2]); h1[2] += bflo(hv[3]); h1[3] += bfhi(hv[3]);
                    store_bf8(p, h0, h1);
                }
            }
    }
};

struct Epi6S {
    static constexpr int NPART = 1;
    float* scr;
    template <int NAI = 2, int NBJ = 2>
    __device__ __forceinline__ void operator()(EPI_ARGS) const {
        const int col0 = u.cb + wc * 32 + 8 * fq;
#pragma unroll
        for (int ai = 0; ai < NAI; ++ai)
#pragma unroll
            for (int m = 0; m < 4; ++m) {
                const int row = u.ra + ai * 128 + wr * 64 + m * 16 + fr;
#pragma unroll
                for (int bj = 0; bj < NBJ; ++bj) { float* p = scr + row * 256 + col0 + bj * 128; *(f32x4*)p = acc[ai][bj][m][0]; *(f32x4*)(p + 4) = acc[ai][bj][m][1]; }
            }
    }
};

__device__ __forceinline__ float wave_sum(float v) {
#pragma unroll
    for (int o = 1; o < 64; o <<= 1) v += __shfl_xor(v, o);
    return v;
}
template <int MODE>
__device__ __forceinline__ void transpose_item(const float* W, int N, bf16_t* WT, int ldt, int coff, LAS float* scr, int item, int lane, const float* g) {
    const int nblk = N / 32, kb = item / nblk, nb = item % nblk, k0 = 64 * kb, n0 = 32 * nb;
#pragma unroll 8
    for (int i = 0; i < 32; ++i) { const int kk = 2 * i + (lane >> 5); float v = W[(size_t)(k0 + kk) * N + n0 + (lane & 31)]; if (MODE >= 1) v *= g[k0 + kk]; scr[kk * 33 + (lane & 31)] = v; }
    asm volatile("s_waitcnt lgkmcnt(0)" ::: "memory");
    const int c = lane & 7;
#pragma unroll
    for (int j = 0; j < 4; ++j) {
        const int n = (lane >> 3) + 8 * j; const LAS float* s = scr + (8 * c) * 33 + n;
        u32x4 o; o.x = cvtpk(s[0 * 33], s[1 * 33]); o.y = cvtpk(s[2 * 33], s[3 * 33]); o.z = cvtpk(s[4 * 33], s[5 * 33]); o.w = cvtpk(s[6 * 33], s[7 * 33]);
        int dr = n0 + n;
        if (MODE == 1) { dr = (dr < DFF) ? 256 * (dr >> 7) + (dr & 127) : 256 * ((dr - DFF) >> 7) + 128 + ((dr - DFF) & 127); }
        if (MODE == 2) {
            if (dr >= 6144) { const int t = dr - 6144, ch = t & 2047; dr = 6144 + 256 * (ch >> 7) + ((t >> 11) << 7) + (ch & 127); }
            else if (dr >= 4096) { const int t = dr - 4096, ch = t & 1023; dr = 4096 + 256 * (ch >> 7) + ((t >> 10) << 7) + (ch & 127); }
        }
        *(u32x4*)(WT + (size_t)dr * ldt + coff + k0 + 8 * c) = o;
    }
    asm volatile("s_waitcnt lgkmcnt(0)" ::: "memory");
}

__device__ __forceinline__ int rel_bucket(int rel) {
    const int n = rel < 0 ? -rel : rel; int b;
    if (n < 8) b = n; else b = n < 12 ? 8 : n < 16 ? 9 : n < 23 ? 10 : n < 32 ? 11 : n < 46 ? 12 : n < 64 ? 13 : n < 91 ? 14 : 15;
    return (rel > 0 ? 16 : 0) + b;
}

namespace att {
constexpr int KSL = 64 * 144, KBUF = 2 * KSL, VBUF = 128 * 144, STAGE = KBUF + VBUF;
constexpr int PER_XCD = 16 + 128;
__device__ __forceinline__ int crow(int r, int hi) { return (r & 3) + 8 * (r >> 2) + 4 * hi; }

struct Ctx { const bf16_t* proj; const bf16_t* kc; const bf16_t* vtc; const bf16_t* vtp; const bf16_t* vtn; bf16_t* oob; const float* subln; float lam; float* out; };

__device__ __forceinline__ void unit(const Ctx& C, int xq, int idx, LAS unsigned char* lds) {
    bool samp; int b, h, cp;
    if (idx < 16) { samp = true; const int s_ = xq * 16 + idx; b = s_ >> 3; h = s_ & 7; cp = 8; }
    else { samp = false; const int v = idx - 16, id = xq * 4 + (v >> 5); b = id >> 3; h = id & 7; cp = 31 - (v & 31); }
    const int nt = samp ? 17 : 2 * cp + 2;
    const int tid = threadIdx.x, lane = tid & 63, wid = __builtin_amdgcn_readfirstlane(tid >> 6);
    const int q = lane & 31, hi = lane >> 5, mp = wid >> 2, rb = wid & 3;
    const int cw = samp ? 16 : 2 * cp + (rb >> 1);
    const bool valid = !samp || rb < 2;
    const int qrow = samp ? MP + b * 64 + 32 * (rb & 1) + q : b * SEQ + 128 * cp + 32 * rb + q;
    bf16x8 qf[4];
    { const bf16_t* qp = C.proj + (size_t)qrow * PLD + PC_Q + h * 128 + mp * 64 + hi * 8;
#pragma unroll
      for (int d0 = 0; d0 < 4; ++d0) qf[d0] = *(const bf16x8*)(qp + d0 * 16); }
    u32x4 krA[2], vrA[2], krB[2], vrB[2];
#define ATT_LOAD(j, kr, vr) do { const bf16_t* kp_; const bf16_t* vp_; size_t kpi_, vpi_; \
        if (!samp) { kp_ = C.proj + ((size_t)b * SEQ + 64 * (j)) * PLD + PC_K + h * 128; kpi_ = PLD; vp_ = C.vtp + ((size_t)(b * 8 + h) * 128) * SEQ + 64 * (j); vpi_ = SEQ; } \
        else if ((j) < 16) { kp_ = C.kc + ((size_t)b * PAST + 64 * (j)) * 1024 + h * 128; kpi_ = 1024; vp_ = C.vtc + ((size_t)(b * 8 + h) * 128) * PAST + 64 * (j); vpi_ = PAST; } \
        else { kp_ = C.proj + ((size_t)MP + b * 64) * PLD + PC_K + h * 128; kpi_ = PLD; vp_ = C.vtn + ((size_t)(b * 8 + h) * 128) * 64; vpi_ = 64; } \
        _Pragma("unroll") for (int i_ = 0; i_ < 2; ++i_) { const int id_ = tid + 512 * i_; \
            kr[i_] = *(const u32x4*)(kp_ + (size_t)(id_ >> 4) * kpi_ + (id_ & 15) * 8); vr[i_] = *(const u32x4*)(vp_ + (size_t)(id_ >> 3) * vpi_ + (id_ & 7) * 8); } } while (0)
#define ATT_STORE(buf, kr, vr) do { LAS unsigned char* sb_ = lds + (buf) * STAGE; \
        _Pragma("unroll") for (int i_ = 0; i_ < 2; ++i_) { const int id_ = tid + 512 * i_; \
            *(LAS u32x4*)(sb_ + ((id_ & 15) >> 3) * KSL + (id_ >> 4) * 144 + (id_ & 7) * 16) = kr[i_]; *(LAS u32x4*)(sb_ + KBUF + (id_ >> 3) * 144 + (id_ & 7) * 16) = vr[i_]; } } while (0)
    ATT_LOAD(0, krA, vrA); ATT_STORE(0, krA, vrA);
    if (nt > 1) ATT_LOAD(1, krA, vrA);
    if (nt > 2) ATT_LOAD(2, krB, vrB);
    __syncthreads();
    const int pi = 16 * (q >> 4) + 8 * ((q >> 2) & 1) + 4 * ((q >> 3) & 1) + (q & 3);
    const int koff = mp * KSL + pi * 144 + hi * 16;
    const int voff = KBUF + q * 144 + hi * 16;
    const LAS float* tab = (const LAS float*)(lds + TAB_OFF) + h * 256;
    const float b15 = tab[0];
    constexpr float C2 = 0.125f * LOG2E;
    f32x16 O[4];
#pragma unroll
    for (int i = 0; i < 4; ++i)
#pragma unroll
        for (int r = 0; r < 16; ++r) O[i][r] = 0.f;
    float mrun = -1e30f, lrun = 0.f;
    auto tile = [&](const LAS unsigned char* sb, int j) __attribute__((always_inline)) {

        f32x16 S0, S1;
#pragma unroll
        for (int r = 0; r < 16; ++r) { S0[r] = 0.f; S1[r] = 0.f; }
#pragma unroll
        for (int d0 = 0; d0 < 4; ++d0) {
            const bf16x8 a0 = *(const LAS bf16x8*)(sb + koff + d0 * 32), a1 = *(const LAS bf16x8*)(sb + koff + 32 * 144 + d0 * 32);
            S0 = __builtin_amdgcn_mfma_f32_32x32x16_bf16(a0, qf[d0], S0, 0, 0, 0);
            S1 = __builtin_amdgcn_mfma_f32_32x32x16_bf16(a1, qf[d0], S1, 0, 0, 0);
        }
        if (j + 3 <= cw) {
#pragma unroll
            for (int r = 0; r < 16; ++r) { float a_ = __builtin_fmaf(S0[r], C2, b15), b_ = __builtin_fmaf(S1[r], C2, b15); asm("" : "+v"(a_)); asm("" : "+v"(b_)); S0[r] = a_; S1[r] = b_; }
        } else {
            const LAS float* tb = tab + (64 * (j - cw) + 8 * hi - 32 * (rb & 1) - q + 191);
#pragma unroll
            for (int r = 0; r < 16; ++r) { S0[r] = S0[r] * C2 + tb[16 * (r >> 3) + (r & 7)]; S1[r] = S1[r] * C2 + tb[32 + 16 * (r >> 3) + (r & 7)]; }
        }
        float rm = __builtin_fmaxf(__builtin_fmaxf(S0[0], S1[0]), S0[1]);
        rm = __builtin_fmaxf(__builtin_fmaxf(rm, S1[1]), S0[2]); rm = __builtin_fmaxf(__builtin_fmaxf(rm, S1[2]), S0[3]);
#pragma unroll
        for (int r = 3; r < 15; r += 2) { rm = __builtin_fmaxf(__builtin_fmaxf(rm, S1[r]), S0[r + 1]); rm = __builtin_fmaxf(__builtin_fmaxf(rm, S1[r + 1]), S0[r + 2]); }
        rm = __builtin_fmaxf(rm, S1[15]);
        { float ra = rm, rbv = rm; swap32(ra, rbv); rm = __builtin_fmaxf(ra, rbv); }
        if (__any(rm > mrun + 8.f)) {
            const float mn = __builtin_fmaxf(mrun, rm), al = __builtin_amdgcn_exp2f(mrun - mn);
            mrun = mn; lrun *= al;
#pragma unroll
            for (int i = 0; i < 4; ++i)
#pragma unroll
                for (int r = 0; r < 16; ++r) O[i][r] *= al;
        }
        float ls0 = 0.f, ls1 = 0.f;
#pragma unroll
        for (int r = 0; r < 16; ++r) {
            float a_ = __builtin_amdgcn_exp2f(S0[r] - mrun), b_ = __builtin_amdgcn_exp2f(S1[r] - mrun);
            S0[r] = a_; S1[r] = b_; ls0 += a_; asm("" : "+v"(ls0)); ls1 += b_; asm("" : "+v"(ls1));
        }
        lrun += ls0 + ls1;
        bf16x8 pb[4];
#pragma unroll
        for (int mm = 0; mm < 2; ++mm) {
            u32x4 w0, w1;
            w0.x = cvtpk(S0[8 * mm + 0], S0[8 * mm + 1]); w0.y = cvtpk(S0[8 * mm + 2], S0[8 * mm + 3]); w0.z = cvtpk(S0[8 * mm + 4], S0[8 * mm + 5]); w0.w = cvtpk(S0[8 * mm + 6], S0[8 * mm + 7]);
            w1.x = cvtpk(S1[8 * mm + 0], S1[8 * mm + 1]); w1.y = cvtpk(S1[8 * mm + 2], S1[8 * mm + 3]); w1.z = cvtpk(S1[8 * mm + 4], S1[8 * mm + 5]); w1.w = cvtpk(S1[8 * mm + 6], S1[8 * mm + 7]);
            pb[mm] = __builtin_bit_cast(bf16x8, w0); pb[2 + mm] = __builtin_bit_cast(bf16x8, w1);
        }
#pragma unroll
        for (int kk = 0; kk < 4; ++kk)
#pragma unroll
            for (int i = 0; i < 4; ++i) {
                const bf16x8 av = *(const LAS bf16x8*)(sb + voff + i * 32 * 144 + kk * 32);
                O[i] = __builtin_amdgcn_mfma_f32_32x32x16_bf16(av, pb[kk], O[i], 0, 0, 0);
            }
    };
    auto kv_out = [&](const LAS unsigned char* sb, int j) __attribute__((always_inline)) {
        const size_t row0 = samp ? (size_t)b * 64 : (size_t)b * SEQ + 64 * j;
        float* ko = C.out + (samp ? O_KS : O_KP) + row0 * 1024 + h * 128; float* vo = C.out + (samp ? O_VS : O_VP) + row0 * 1024 + h * 128;
        { const int key = tid >> 3, part = tid & 7; const LAS unsigned char* p = sb + (part >> 2) * KSL + key * 144 + (part & 3) * 32;
          const u32x4 w0 = *(const LAS u32x4*)p, w1 = *(const LAS u32x4*)(p + 16); float* o = ko + (size_t)key * 1024 + part * 16;
          *(f32x4*)o = (f32x4){bflo(w0[0]), bfhi(w0[0]), bflo(w0[1]), bfhi(w0[1])}; *(f32x4*)(o + 4) = (f32x4){bflo(w0[2]), bfhi(w0[2]), bflo(w0[3]), bfhi(w0[3])};
          *(f32x4*)(o + 8) = (f32x4){bflo(w1[0]), bfhi(w1[0]), bflo(w1[1]), bfhi(w1[1])}; *(f32x4*)(o + 12) = (f32x4){bflo(w1[2]), bfhi(w1[2]), bflo(w1[3]), bfhi(w1[3])}; }
        { const int key = tid & 63, dv0 = (tid >> 6) * 16; const LAS unsigned short* p = (const LAS unsigned short*)(sb + KBUF + dv0 * 144 + key * 2); float* o = vo + (size_t)key * 1024 + dv0;
#pragma unroll
          for (int g4 = 0; g4 < 4; ++g4) *(f32x4*)(o + 4 * g4) = (f32x4){bf2f(p[(4 * g4 + 0) * 72]), bf2f(p[(4 * g4 + 1) * 72]), bf2f(p[(4 * g4 + 2) * 72]), bf2f(p[(4 * g4 + 3) * 72])}; }
    };
    const int jo = samp ? 16 : nt - 2;
    for (int j = 0; j < nt; j += 2) {
        if (valid && j <= cw) tile(lds, j);
        if (j >= jo) kv_out(lds, j);
        if (j + 1 < nt) ATT_STORE(1, krA, vrA);
        if (j + 3 < nt) ATT_LOAD(j + 3, krA, vrA);
        __syncthreads();
        if (j + 1 >= nt) break;
        if (valid && j + 1 <= cw) tile(lds + STAGE, j + 1);
        if (j + 1 >= jo) kv_out(lds + STAGE, j + 1);
        if (j + 2 < nt) ATT_STORE(0, krB, vrB);
        if (j + 4 < nt) ATT_LOAD(j + 4, krB, vrB);
        __syncthreads();
    }
#undef ATT_LOAD
#undef ATT_STORE
    { float ra = lrun, rbv = lrun; swap32(ra, rbv); lrun = ra + rbv; }
    const float inv = 1.0f / lrun;
    LAS float* X = (LAS float*)lds + rb * 4096;
    if (mp == 1 && valid) {
#pragma unroll
        for (int i = 0; i < 4; ++i)
#pragma unroll
            for (int r = 0; r < 16; ++r) X[(32 * i + crow(r, hi)) * 32 + q] = O[i][r] * inv;
    }
    __syncthreads();
    if (mp == 0 && valid) {
        float ss = 0.f;
#pragma unroll
        for (int i = 0; i < 4; ++i)
#pragma unroll
            for (int r = 0; r < 16; ++r) { const float o = O[i][r] * inv - C.lam * X[(32 * i + crow(r, hi)) * 32 + q]; O[i][r] = o; ss += o * o; }
        { float ra = ss, rbv = ss; swap32(ra, rbv); ss = ra + rbv; }
        const float rn = __builtin_amdgcn_rsqf(ss * (1.0f / DV) + EPS) * 0.8f;
        bf16_t* op = C.oob + (size_t)qrow * DM + h * 128;
#pragma unroll
        for (int i = 0; i < 4; ++i)
#pragma unroll
            for (int g4 = 0; g4 < 4; ++g4) {
                const int dv0 = 32 * i + 8 * g4 + 4 * hi; const f32x4 sg = *(const f32x4*)(C.subln + dv0);
                u32x2 w; w.x = cvtpk(O[i][4 * g4 + 0] * rn * sg[0], O[i][4 * g4 + 1] * rn * sg[1]); w.y = cvtpk(O[i][4 * g4 + 2] * rn * sg[2], O[i][4 * g4 + 3] * rn * sg[3]);
                *(u32x2*)(op + dv0) = w;
            }
    }
    __syncthreads();
}
}

#define RLX_AGENT __ATOMIC_RELAXED, __HIP_MEMORY_SCOPE_AGENT
#define XB_TMO      128
#define XB_XCNT(j)  (256  + 64 * (j))
#define XB_XSUB(j)  (1280 + 64 * (j))
#define XB_XGEN(j)  (2304 + 64 * (j))
#define XB_TOP      3328
#define XB_TOPGEN   3392
#define XCD_BAR_WORDS 3456
#define XB_SPIN_CAP (1u << 18)

__device__ __forceinline__ unsigned xb_ld(unsigned* p)              { return __hip_atomic_load(p, __ATOMIC_RELAXED, __HIP_MEMORY_SCOPE_AGENT); }
__device__ __forceinline__ unsigned xb_add(unsigned* p, unsigned v) { return __hip_atomic_fetch_add(p, v, __ATOMIC_RELAXED, __HIP_MEMORY_SCOPE_AGENT); }
__device__ __forceinline__ unsigned xb_xcc_id() { return (unsigned)__builtin_amdgcn_s_getreg((3 << 11) | 20) & 0xFu; }
#define XB_SPIN(cond, bar) do { unsigned _sp = 0; while (cond) { __builtin_amdgcn_s_sleep(1); \
    if ((++_sp & 255u) == 0u) { if (xb_ld(&(bar)[XB_TMO])) break; if (_sp > XB_SPIN_CAP) { atomicAdd(&(bar)[XB_TMO], 1u); break; } } } } while (0)

struct XcdBarrier {
    unsigned* bar; unsigned x;
    volatile LAS unsigned* st;
};

__device__ __forceinline__ XcdBarrier xcd_barrier_post(unsigned* bar, volatile LAS unsigned* st) {
    XcdBarrier b; b.bar = bar; b.x = xb_xcc_id(); b.st = st;
    if (threadIdx.x == 0) (void)xb_add(&bar[XB_XCNT(b.x)], 1u);
    return b;
}
__device__ __forceinline__ void xcd_barrier_complete(unsigned* bar, unsigned x, unsigned& nloc, unsigned& nx) {
    const unsigned G = gridDim.x * gridDim.y * gridDim.z;
    unsigned sum, cnt, mine, sp = 0u;
    for (;;) {
        sum = 0u; cnt = 0u; mine = 0u;
#pragma unroll
        for (unsigned j = 0; j < 16; ++j) { const unsigned c = xb_ld(&bar[XB_XCNT(j)]); sum += c; cnt += (c > 0u) ? 1u : 0u; mine = (j == x) ? c : mine; }
        if (sum == G) break;
        __builtin_amdgcn_s_sleep(1);
        if ((++sp & 255u) == 0u) { if (xb_ld(&bar[XB_TMO])) break; if (sp > XB_SPIN_CAP) { atomicAdd(&bar[XB_TMO], 1u); break; } }
    }
    nloc = mine > 0u ? mine : 1u; nx = cnt > 0u ? cnt : 1u;
}

__device__ __forceinline__ void xcd_barrier(const XcdBarrier& b) {
    asm volatile("s_waitcnt vmcnt(0)" ::: "memory");
    __syncthreads();
    if (threadIdx.x == 0) {
        unsigned* bar = b.bar;
        __builtin_amdgcn_s_waitcnt(0);
        unsigned nloc = b.st[0], nx = b.st[1];
        if (nloc == 0u) { xcd_barrier_complete(bar, b.x, nloc, nx); b.st[0] = nloc; b.st[1] = nx; }
        const unsigned old = xb_add(&bar[XB_XSUB(b.x)], 1u);
        const unsigned gen = old / nloc;
        if (old + 1u == (gen + 1u) * nloc) {
            __builtin_amdgcn_fence(__ATOMIC_RELEASE, "agent");
            asm volatile("s_waitcnt vmcnt(0)" ::: "memory");
            const unsigned og = xb_add(&bar[XB_TOP], 1u);
            const unsigned tg = og / nx;
            if (og + 1u == (tg + 1u) * nx) xb_add(&bar[XB_TOPGEN], 1u);
            else XB_SPIN(xb_ld(&bar[XB_TOPGEN]) == tg, bar);
            __builtin_amdgcn_fence(__ATOMIC_ACQUIRE, "agent");
            xb_add(&bar[XB_XGEN(b.x)], 1u);
            asm volatile("s_waitcnt vmcnt(0)" ::: "memory");
        } else {
            XB_SPIN(xb_ld(&bar[XB_XGEN(b.x)]) == gen, bar);
            __builtin_amdgcn_fence(__ATOMIC_ACQUIRE, "agent");
            asm volatile("s_waitcnt vmcnt(0)" ::: "memory");
        }
    }
    __syncthreads();
}


struct Args { const float* in[23]; float* out; unsigned char* ws; int ph_lo, ph_hi; };
enum { I_XP = 0, I_XS, I_CK, I_CV, I_SCM, I_SCF, I_RB, I_N1, I_WIN, I_LQ1, I_LK1, I_LQ2, I_LK2, I_SUB, I_CW, I_WA, I_WB, I_WO, I_N2, I_WUP, I_FCW, I_WDN, I_FG };
constexpr int NPH = 9;

__global__ void __launch_bounds__(512, 2) mk_fwd(Args a) {
    extern __shared__ __attribute__((aligned(16))) unsigned char lds_raw[];
    LAS unsigned char* lds = (LAS unsigned char*)lds_raw;
    const int tid = threadIdx.x, lane = tid & 63, wave = __builtin_amdgcn_readfirstlane(tid >> 6);
    const int G = gridDim.x, bx = blockIdx.x;
    const int gw = bx * 8 + wave, NGW = G * 8;
    unsigned char* ws = a.ws; float* out = a.out;
    unsigned* ctl = (unsigned*)(ws + WS_CTL); float* rowss = (float*)(ws + WS_ROWSS);
    bf16_t* WIN = (bf16_t*)(ws + WS_WIN); bf16_t* WAB = (bf16_t*)(ws + WS_WAB); bf16_t* WO = (bf16_t*)(ws + WS_WO);
    bf16_t* PROJ = (bf16_t*)(ws + WS_PROJ); bf16_t* KC = (bf16_t*)(ws + WS_KC); bf16_t* VTC = (bf16_t*)(ws + WS_VTC);
    bf16_t* VTP = (bf16_t*)(ws + WS_VTP); bf16_t* VTN = (bf16_t*)(ws + WS_VTN); bf16_t* MERGED = (bf16_t*)(ws + WS_MERGED);
    bf16_t* WUP = (bf16_t*)(ws + WS_WUP); bf16_t* WDN = (bf16_t*)(ws + WS_WDN); bf16_t* HB = (bf16_t*)(ws + WS_HB);
    bf16_t* ACT = (bf16_t*)(ws + WS_ACT); float* TH = (float*)(ws + WS_TH);
    bf16_t* XB = (bf16_t*)(out + O_Y) + (size_t)MTOT * DM;
    bf16_t* OOB = (bf16_t*)(out + O_Y); float* rstd1 = (float*)(ws + WS_RSTD1);
    const int lo = a.ph_lo, hi_ = a.ph_hi;
#ifndef PH_MASK
#define PH_MASK 0x1ff
#endif
#define IN(k) (((PH_MASK >> (k)) & 1) && lo <= (k) && (k) < hi_)
    const int QLIM = (G == 256) ? 512 : 0x7fffffff;
#define QUARTERS(EPI) if (G == 256 && bx < 128) { Unit qu; S.unit_of(512 + (bx >> 2), qu); qu.ra = ((bx >> 1) & 1) * 128; qu.cb = (bx & 1) * 128; pg8::gemm_quarter<EPI>(lds, g, qu, E); }
    volatile LAS unsigned* bst = (volatile LAS unsigned*)(lds + MISC_OFF + 32);
    if (tid < 2) bst[tid] = 0u;
    __syncthreads();
    XcdBarrier xbar = xcd_barrier_post(ctl + 4096, bst);
    if (a.ph_hi > NPH) cg::this_grid().sync();
#define SEAM(k) do { if (IN(k) && IN((k) + 1)) xcd_barrier(xbar); } while (0)
    LAS float* scr = (LAS float*)(lds + wave * 16384);

    for (int rep_ = 0; rep_ < (PROBE_DUP == 100 ? 2 : 1); ++rep_)
    if (IN(0)) {
        constexpr int I_IN = 32 * 320, I_A = 16 * 64, I_O = 32 * 64, I_V = 16 * 32;
        constexpr int NIT = I_IN + 2 * I_A + I_O + 16 * I_V;
        for (int it = gw; it < NIT; it += NGW) {
            int r = it;
            if (r < I_IN) { transpose_item<2>(a.in[I_WIN], NIN, WIN, DM, 0, scr, r, lane, a.in[I_N1]); continue; } r -= I_IN;
            if (r < I_A) { transpose_item<0>(a.in[I_WA], DM, WAB, 2048, 0, scr, r, lane, nullptr); continue; } r -= I_A;
            if (r < I_A) { transpose_item<0>(a.in[I_WB], DM, WAB, 2048, 1024, scr, r, lane, nullptr); continue; } r -= I_A;
            if (r < I_O) { transpose_item<0>(a.in[I_WO], DM, WO, DM, 0, scr, r, lane, nullptr); continue; } r -= I_O;
            { const int bb = r / I_V; transpose_item<0>(a.in[I_CV] + (size_t)bb * PAST * 1024, 1024, VTC + (size_t)bb * 1024 * PAST, PAST, 0, scr, r % I_V, lane, nullptr); }
        }
        for (int m = gw; m < MTOT; m += NGW) {
            const float* xr = (m < MP) ? a.in[I_XP] + (size_t)m * DM : a.in[I_XS] + (size_t)(m - MP) * DM;
            f32x4 v[8]; float s = 0.f;
#pragma unroll
            for (int j = 0; j < 8; ++j) { v[j] = *(const f32x4*)(xr + 4 * lane + 256 * j); s += (v[j][0] * v[j][0] + v[j][1] * v[j][1]) + (v[j][2] * v[j][2] + v[j][3] * v[j][3]); }
            const float rstd = __builtin_amdgcn_rsqf(wave_sum(s) * (1.0f / DM) + EPS);
            if (lane == 0) rstd1[m] = rstd;
#pragma unroll
            for (int j = 0; j < 8; ++j) { u32x2 w; w.x = cvtpk(v[j][0], v[j][1]); w.y = cvtpk(v[j][2], v[j][3]);
                *(u32x2*)(XB + (size_t)m * DM + 4 * lane + 256 * j) = w; }
        }
        for (size_t i = (size_t)gw; i < (size_t)DBATCH * PAST * 1024 / 512; i += NGW) {
            const float* s = a.in[I_CK] + i * 512 + lane * 8; const f32x4 v0 = *(const f32x4*)s, v1 = *(const f32x4*)(s + 4);
            store_bf8(KC + i * 512 + lane * 8, v0, v1);
        }
    }
    SEAM(0);
    if (IN(1)) {
        pg8::Gemm g{XB, WIN, DM, DM, DM}; pg8::StaticOrder S; S.init(MTOT / 256, NIN / 256, G, bx);
        Epi1 E{PROJ, out, VTP, VTN, rstd1};
        pg8::gemm_phase<Epi1>(lds, g, S, E);
    }
    SEAM(1);
    if (IN(2)) {
        for (int i = tid; i < 8 * 256; i += 512) { const int hh = i >> 8, rel = (i & 255) - 191; ((LAS float*)(lds + TAB_OFF))[i] = a.in[I_RB][rel_bucket(rel) * NH + hh] * LOG2E; }
        float d1 = 0.f, d2 = 0.f;
        for (int i = 0; i < 64; ++i) { d1 += a.in[I_LQ1][i] * a.in[I_LK1][i]; d2 += a.in[I_LQ2][i] * a.in[I_LK2][i]; }
        att::Ctx C{PROJ, KC, VTC, VTP, VTN, OOB, a.in[I_SUB], __expf(d1) - __expf(d2) + 0.2f, out};
        LAS int* misc = (LAS int*)(lds + MISC_OFF);
        __syncthreads();
        for (int rep_ = 0; rep_ < (PROBE_DUP == 2 ? 2 : 1); ++rep_)
        for (int qi = 0; qi < 8; ++qi) {
            const int xq = (bx + qi) & 7;
            for (;;) {
                if (tid == 0) misc[0] = (int)atomicAdd(ctl + 64 * (xq + 8 * rep_), 1u);
                __syncthreads();
                const int idx = misc[0];
                __syncthreads();
                if (idx >= att::PER_XCD) break;
                att::unit(C, xq, idx, lds);
            }
        }
        const float* cwm = a.in[I_CW];
        for (int it = bx * 512 + tid; it < (MTOT / 8) * 128; it += G * 512) {
            const int cg8 = it & 127, r0 = (it >> 7) * 8, ch = cg8 * 8;
            const bool samp = r0 >= MP; const int t0 = samp ? ((r0 - MP) & 63) : (r0 & (SEQ - 1));
            float w0[8], w1[8], w2[8], u1[8], u2[8];
#pragma unroll
            for (int e = 0; e < 8; ++e) { w0[e] = cwm[ch + e]; w1[e] = cwm[1024 + ch + e]; w2[e] = cwm[2048 + ch + e]; }
            if (t0 == 0) {
                if (samp) { const float* st = a.in[I_SCM] + (size_t)((r0 - MP) >> 6) * 2048 + ch;
#pragma unroll
                    for (int e = 0; e < 8; ++e) { u2[e] = st[e]; u1[e] = st[1024 + e]; } }
                else {
#pragma unroll
                    for (int e = 0; e < 8; ++e) { u2[e] = 0.f; u1[e] = 0.f; } }
            } else {
                const bf16_t* p2 = PROJ + (size_t)(r0 - 2) * PLD + ch; const bf16_t* p1 = p2 + PLD;
                const u32x4 c2 = *(const u32x4*)(p2 + PC_C), c1 = *(const u32x4*)(p1 + PC_C);
#pragma unroll
                for (int w = 0; w < 4; ++w) { u2[2 * w] = bflo(c2[w]); u2[2 * w + 1] = bfhi(c2[w]); u1[2 * w] = bflo(c1[w]); u1[2 * w + 1] = bfhi(c1[w]); }
            }
#pragma unroll
            for (int rr = 0; rr < 8; ++rr) {
                const int row = r0 + rr; const bf16_t* p = PROJ + (size_t)row * PLD + ch;
                const u32x4 cc = *(const u32x4*)(p + PC_C), bb = *(const u32x4*)(p + PC_B);
                float uu[8], ob[8];
#pragma unroll
                for (int w = 0; w < 4; ++w) { uu[2 * w] = bflo(cc[w]); uu[2 * w + 1] = bfhi(cc[w]); }
#pragma unroll
                for (int w = 0; w < 4; ++w) {
                    ob[2 * w] = bflo(bb[w]) * (w0[2 * w] * u2[2 * w] + w1[2 * w] * u1[2 * w] + w2[2 * w] * uu[2 * w]);
                    ob[2 * w + 1] = bfhi(bb[w]) * (w0[2 * w + 1] * u2[2 * w + 1] + w1[2 * w + 1] * u1[2 * w + 1] + w2[2 * w + 1] * uu[2 * w + 1]);
                }
                u32x4 o; o.x = cvtpk(ob[0], ob[1]); o.y = cvtpk(ob[2], ob[3]); o.z = cvtpk(ob[4], ob[5]); o.w = cvtpk(ob[6], ob[7]);
                *(u32x4*)(OOB + (size_t)row * DM + 1024 + ch) = o;
                const int t = t0 + rr;
                if (samp ? (t >= DSEQ - 2) : (t >= SEQ - 2)) {
                    float* so = samp ? out + O_CMS + (size_t)(((row - MP) >> 6) * 2 + (t - (DSEQ - 2))) * 1024 + ch : out + O_CMP + (size_t)((row >> 12) * 2 + (t - (SEQ - 2))) * 1024 + ch;
                    *(f32x4*)so = (f32x4){uu[0], uu[1], uu[2], uu[3]}; *(f32x4*)(so + 4) = (f32x4){uu[4], uu[5], uu[6], uu[7]};
                }
#pragma unroll
                for (int e = 0; e < 8; ++e) { u2[e] = u1[e]; u1[e] = uu[e]; }
            }
        }
    }
    SEAM(2);
    if (IN(3)) {
        constexpr int I_U = 32 * 352, I_D = 88 * 64;
        for (int it = gw; it < I_U + I_D; it += NGW) {
            if (it < I_U) transpose_item<1>(a.in[I_WUP], 2 * DFF, WUP, DM, 0, scr, it, lane, a.in[I_N2]);
            else transpose_item<0>(a.in[I_WDN], DM, WDN, DFF, 0, scr, it - I_U, lane, nullptr);
        }
        __syncthreads();
        pg8::Gemm g{OOB, WAB, DM, DM, 1024}; pg8::StaticOrder S; S.init(MTOT / 256, DM / 256, G, bx, QLIM);
        Epi3 E{PROJ, MERGED};
        QUARTERS(Epi3)
        pg8::gemm_phase<Epi3>(lds, g, S, E);
    }
    SEAM(3);
    if (IN(4)) {
        pg8::Gemm g{MERGED, WO, DM, DM, DM}; pg8::StaticOrder S; S.init(MTOT / 256, DM / 256, G, bx, QLIM);
        Epi4 E{XB, HB, rowss};
        QUARTERS(Epi4)
        pg8::gemm_phase<Epi4>(lds, g, S, E);
    }
    SEAM(4);
    if (IN(5)) {
        pg8::Gemm g{HB, WUP, DM, DM, DM}; pg8::StaticOrder S; S.init(MTOT / 256, (2 * DFF) / 256, G, bx);
        Epi5 E{rowss, a.in[I_FCW], a.in[I_SCF], ACT, TH, out, lds + XB_OFF};
        pg8::gemm_phase<Epi5>(lds, g, S, E);
    }
    SEAM(5);
    if (IN(6)) {
        const float* cw = a.in[I_FCW];
        for (int it = bx * 512 + tid; it < 64 * DFF; it += G * 512) {
            const int pm = it / DFF, ch = it - pm * DFF;
            if ((pm & 15) == 0) continue;
            float yv[2][2];
#pragma unroll
            for (int bj = 0; bj < 2; ++bj) {
                const int gc = bj * DFF + ch;
                const float t2 = TH[(size_t)((pm - 1) * 4 + 2) * (2 * DFF) + gc], t3 = TH[(size_t)((pm - 1) * 4 + 3) * (2 * DFF) + gc];
                const float h0 = TH[(size_t)(pm * 4 + 0) * (2 * DFF) + gc], h1 = TH[(size_t)(pm * 4 + 1) * (2 * DFF) + gc];
                const float w0 = cw[gc], w1 = cw[2 * DFF + gc], w2 = cw[4 * DFF + gc];
                yv[bj][0] = w0 * t2 + w1 * t3 + w2 * h0; yv[bj][1] = w0 * t3 + w1 * h0 + w2 * h1;
            }
#pragma unroll
            for (int r = 0; r < 2; ++r) ACT[(size_t)(pm * 256 + r) * DFF + ch] = (bf16_t)(cvtpk(yv[0][r] * sigmoidf_(yv[0][r]) * yv[1][r], 0.f) & 0xffffu);
        }
    }
    SEAM(6);
    if (IN(7)) {
        pg8::Gemm g{ACT, WDN, DFF, DFF, DFF}; pg8::StaticOrder S; S.init(MTOT / 256, DM / 256, G, bx, QLIM);
        Epi6 E{HB};
        if (G == 256) {
            const int qi = bx >> 1, kh = bx & 1;
            Unit qu; S.unit_of(512 + (qi >> 2), qu); qu.ra = ((qi >> 1) & 1) * 128; qu.cb = (qi & 1) * 128;
            pg8::Gemm g2{ACT + kh * (DFF / 2), WDN + kh * (DFF / 2), DFF, DFF, DFF / 2};
            Epi6S E2{(float*)(ws + WS_SCR6) + ((size_t)kh * 32 + (qi >> 2)) * 65536};
            pg8::gemm_quarter<Epi6S>(lds, g2, qu, E2);
        }
        pg8::gemm_phase<Epi6>(lds, g, S, E);
    }
    SEAM(7);
    if (IN(8)) {
        LAS int* tabq = (LAS int*)lds;
        for (int i = tid; i < 68 * 8; i += 512) tabq[i] = -1;
        __syncthreads();
        if (G == 256 && tid < 32) { pg8::StaticOrder S; S.init(MTOT / 256, DM / 256, G, bx, QLIM); Unit qu; S.unit_of(512 + tid, qu); tabq[qu.pm * 8 + qu.pn] = tid; }
        __syncthreads();
        const float* scr6 = (const float*)(ws + WS_SCR6);
        for (int m = gw; m < MTOT; m += NGW) {
            const bf16_t* hr = HB + (size_t)m * DM; float* yr = out + O_Y + (size_t)m * DM;
            f32x4 v[4][2]; float s2 = 0.f;
#pragma unroll
            for (int j = 0; j < 4; ++j) {
                const u32x4 hv = *(const u32x4*)(hr + 8 * lane + 512 * j);
                v[j][0] = (f32x4){bflo(hv[0]), bfhi(hv[0]), bflo(hv[1]), bfhi(hv[1])}; v[j][1] = (f32x4){bflo(hv[2]), bfhi(hv[2]), bflo(hv[3]), bfhi(hv[3])};
                const int qidx = tabq[(m >> 8) * 8 + 2 * j + (lane >> 5)];
                if (qidx >= 0) {
                    const float* p0 = scr6 + ((size_t)qidx * 256 + (m & 255)) * 256 + 8 * (lane & 31); const float* p1 = p0 + (size_t)32 * 65536;
                    v[j][0] += *(const f32x4*)p0 + *(const f32x4*)p1; v[j][1] += *(const f32x4*)(p0 + 4) + *(const f32x4*)(p1 + 4);
                }
#pragma unroll
                for (int e = 0; e < 4; ++e) s2 += v[j][0][e] * v[j][0][e] + v[j][1][e] * v[j][1][e];
            }
            const float rstd = __builtin_amdgcn_rsqf(wave_sum(s2) * (1.0f / DM) + EPS);
#pragma unroll
            for (int j = 0; j < 4; ++j) { const float* gp = a.in[I_FG] + 8 * lane + 512 * j; const f32x4 g0 = *(const f32x4*)gp, g1 = *(const f32x4*)(gp + 4);
                *(f32x4*)(yr + 8 * lane + 512 * j) = v[j][0] * rstd * g0; *(f32x4*)(yr + 8 * lane + 512 * j + 4) = v[j][1] * rstd * g1; }
        }
    }
#undef IN
#undef SEAM
}

extern "C" void kernel_launch(void* const* d_in, const int* in_sizes, int n_in, void* d_out, int out_size, void* d_ws, size_t ws_size, hipStream_t stream) {
    static int grid = 0;
    if (grid == 0) {
        if (n_in != 23 || (size_t)out_size != O_END || ws_size < WS_END) { fprintf(stderr, "kernel_launch: unexpected shapes: n_in %d out %d ws %zu\n", n_in, out_size, ws_size); grid = -1; return; }
        int dev = 0, cus = 0, per_cu = 0;
        hipGetDevice(&dev); hipDeviceGetAttribute(&cus, hipDeviceAttributeMultiprocessorCount, dev);
        if (hipFuncSetAttribute((const void*)mk_fwd, hipFuncAttributeMaxDynamicSharedMemorySize, LDS_BYTES) != hipSuccess) { fprintf(stderr, "kernel_launch: hipFuncSetAttribute failed\n"); grid = -1; return; }
        if (hipOccupancyMaxActiveBlocksPerMultiprocessor(&per_cu, (const void*)mk_fwd, 512, LDS_BYTES) != hipSuccess || per_cu < 1) { fprintf(stderr, "kernel_launch: occupancy query says %d\n", per_cu); per_cu = 1; }
        (void)hipGetLastError();
        grid = cus * 1;
    }
    if (grid < 0) return;
    (void)hipMemsetAsync((char*)d_ws + WS_CTL, 0, CTL_BYTES, stream);
    Args a{};
    for (int i = 0; i < 23; ++i) a.in[i] = (const float*)d_in[i];
    a.out = (float*)d_out; a.ws = (unsigned char*)d_ws;
#if MK_MULTI
    for (int p = 0; p < NPH; ++p) { a.ph_lo = p; a.ph_hi = p + 1; hipLaunchKernelGGL(mk_fwd, dim3(grid), dim3(512), LDS_BYTES, stream, a); }
#else
    a.ph_lo = 0; a.ph_hi = NPH;
    void* args[] = {&a};
    hipError_t e = hipLaunchCooperativeKernel((const void*)mk_fwd, dim3(grid), dim3(512), args, LDS_BYTES, stream);
    if (e != hipSuccess) fprintf(stderr, "kernel_launch: cooperative launch failed: %s\n", hipGetErrorString(e));
#endif
}
```
